# Optimizing an MI355X kernel written in HIP

```python
import jax
import jax.numpy as jnp
from jax import lax
import numpy as np


D_MODEL = 1024
BATCH = 4
SEQ = 4096
DEPTH = 2

GRID_W = 64
CTX_LEN = 256
Q_BLOCK = 128
ROPE_THETA = 10000.0
EPS = 1e-6

MLA_HEADS = 8
MLA_NOPE = 64
MLA_ROPE = 32
MLA_V = 64
MLA_Q_LORA = 256
MLA_KV_LORA = 128
MLA_SCALE = (MLA_NOPE + MLA_ROPE) ** -0.5
GQA_HEADS = 8
GQA_KV_HEADS = 2
GQA_HEAD_DIM = 64
GQA_SCALE = GQA_HEAD_DIM ** -0.5
ATTN_IN = MLA_Q_LORA + MLA_KV_LORA + MLA_ROPE + (GQA_HEADS + 2 * GQA_KV_HEADS) * GQA_HEAD_DIM
ATTN_OUT = MLA_HEADS * MLA_V + GQA_HEADS * GQA_HEAD_DIM

SSM_HEADS = 16
SSM_HEAD_DIM = 64
SSM_GROUPS = 2
SSM_HPG = SSM_HEADS // SSM_GROUPS
SSM_STATE = 128
SSM_CONV = 5
SSD_CHUNK = 128
SSM_D = SSM_HEADS * SSM_HEAD_DIM
SSM_XBC = SSM_D + 2 * SSM_GROUPS * SSM_STATE
CONF_D = D_MODEL
CONF_K = 31
SSM_IN = SSM_D + SSM_XBC + SSM_HEADS + 2 * CONF_D
SSM_OUT = SSM_D + CONF_D

N_EXPERTS = 32
MOE_TOP_K = 4
MOE_FF = D_MODEL
SWIGLU_LIMIT = 7.0
SWIGLU_ALPHA = 1.702
MOE_BLOCK = 256

N_ATTN_LAYERS = (DEPTH + 1) // 2
N_SSM_LAYERS = DEPTH // 2

kernel_name = 'hybrid_mla_gqa_ssd_conformer_moe_dit'


def rms_norm(x, g):
    xf = x.astype(jnp.float32)
    y = xf * lax.rsqrt(jnp.mean(xf * xf, axis=-1, keepdims=True) + EPS)
    return (y * g.astype(jnp.float32)).astype(x.dtype)


def layer_norm(x, g, b):
    xf = x.astype(jnp.float32)
    mu = jnp.mean(xf, axis=-1, keepdims=True)
    var = jnp.mean(jnp.square(xf - mu), axis=-1, keepdims=True)
    y = (xf - mu) * lax.rsqrt(var + EPS)
    return (y * g.astype(jnp.float32) + b.astype(jnp.float32)).astype(x.dtype)


def modulate(h, shift, scale):
    return h * (1.0 + scale) + shift


def axial_rope_tables(n_tok, rot_dim):
    rows = n_tok // GRID_W
    row = jnp.broadcast_to(jnp.arange(rows, dtype=jnp.float32)[:, None], (rows, GRID_W)).reshape(-1)
    col = jnp.broadcast_to(jnp.arange(GRID_W, dtype=jnp.float32)[None, :], (rows, GRID_W)).reshape(-1)
    n_freq = rot_dim // 4
    inv_freq = ROPE_THETA ** (-jnp.arange(n_freq, dtype=jnp.float32) / n_freq)
    ang = jnp.concatenate([row[:, None] * inv_freq, col[:, None] * inv_freq], axis=-1)
    return jnp.cos(ang), jnp.sin(ang)


def apply_rope(x, cos, sin):
    xp = x.astype(jnp.float32).reshape(x.shape[:-1] + (x.shape[-1] // 2, 2))
    xe, xo = xp[..., 0], xp[..., 1]
    cs, sn = cos[None, :, None, :], sin[None, :, None, :]
    out = jnp.stack([xe * cs - xo * sn, xe * sn + xo * cs], axis=-1)
    return out.reshape(x.shape).astype(x.dtype)


def depthwise_conv(u, w, b):
    k = w.shape[0]
    y = lax.conv_general_dilated(u, w[:, None, :].astype(u.dtype), window_strides=(1,), padding=[(k // 2, k // 2)], dimension_numbers=('NWC', 'WIO', 'NWC'), feature_group_count=u.shape[-1])
    return y + b.astype(u.dtype)


def blocked_attention(q, k, v, scale):
    b, tq, kh, g, dk = q.shape
    nb = tq // Q_BLOCK
    qb = jnp.moveaxis(q.reshape(b, nb, Q_BLOCK, kh, g, dk), 1, 0)

    def one_block(qi):
        s = jnp.einsum('bqhgd,bkhd->bhgqk', qi, k, preferred_element_type=jnp.float32) * scale
        pr = jax.nn.softmax(s, axis=-1).astype(v.dtype)
        return jnp.einsum('bhgqk,bkhd->bqhgd', pr, v)

    o = lax.map(one_block, qb)
    return jnp.moveaxis(o, 0, 1).reshape(b, tq, kh, g, v.shape[-1])


def attn_project(h, w_in, g_cq, w_uq, g_ckv, w_ukv, g_q, g_k):
    b, t, _ = h.shape
    u = h @ w_in
    o1 = MLA_Q_LORA
    o2 = o1 + MLA_KV_LORA
    o3 = o2 + MLA_ROPE
    o4 = o3 + GQA_HEADS * GQA_HEAD_DIM
    o5 = o4 + GQA_KV_HEADS * GQA_HEAD_DIM
    c_q, c_kv, k_rope = u[..., :o1], u[..., o1:o2], u[..., o2:o3]
    q_g, k_g, v_g = u[..., o3:o4], u[..., o4:o5], u[..., o5:]
    q_m = (rms_norm(c_q, g_cq) @ w_uq).reshape(b, t, MLA_HEADS, MLA_NOPE + MLA_ROPE)
    kv_m = (rms_norm(c_kv, g_ckv) @ w_ukv).reshape(b, t, MLA_HEADS, MLA_NOPE + MLA_V)
    k_nope, v_m = kv_m[..., :MLA_NOPE], kv_m[..., MLA_NOPE:]
    k_rope = k_rope.reshape(b, t, 1, MLA_ROPE)
    q_g = rms_norm(q_g.reshape(b, t, GQA_HEADS, GQA_HEAD_DIM), g_q)
    k_g = rms_norm(k_g.reshape(b, t, GQA_KV_HEADS, GQA_HEAD_DIM), g_k)
    v_g = v_g.reshape(b, t, GQA_KV_HEADS, GQA_HEAD_DIM)
    return q_m, k_nope, k_rope, v_m, q_g, k_g, v_g


def mla_keys(k_nope, k_rope):
    return jnp.concatenate([k_nope, jnp.broadcast_to(k_rope, k_nope.shape[:-1] + (MLA_ROPE,))], axis=-1)


def attention_mixer(h_lat, h_ctx, w_in, g_cq, w_uq, g_ckv, w_ukv, g_q, g_k, w_out, ctx_out):
    s = h_lat.shape[1]
    q_m, k_nope, k_rope, v_m, q_g, k_g, v_g = attn_project(h_lat, w_in, g_cq, w_uq, g_ckv, w_ukv, g_q, g_k)
    cq_m, ck_nope, ck_rope, cv_m, cq_g, ck_g, cv_g = attn_project(h_ctx, w_in, g_cq, w_uq, g_ckv, w_ukv, g_q, g_k)
    cos_m, sin_m = axial_rope_tables(s, MLA_ROPE)
    cos_g, sin_g = axial_rope_tables(s, GQA_HEAD_DIM)
    q_m = jnp.concatenate([q_m[..., :MLA_NOPE], apply_rope(q_m[..., MLA_NOPE:], cos_m, sin_m)], axis=-1)
    k_rope = apply_rope(k_rope, cos_m, sin_m)
    q_g = apply_rope(q_g, cos_g, sin_g)
    k_g = apply_rope(k_g, cos_g, sin_g)
    ck_m = mla_keys(ck_nope, ck_rope)
    k_m_all = jnp.concatenate([ck_m, mla_keys(k_nope, k_rope)], axis=1)
    v_m_all = jnp.concatenate([cv_m, v_m], axis=1)
    k_g_all = jnp.concatenate([ck_g, k_g], axis=1)
    v_g_all = jnp.concatenate([cv_g, v_g], axis=1)

    def heads_out(qm, km, vm, qg, kg, vg):
        b, t = qm.shape[:2]
        o_m = blocked_attention(qm[:, :, :, None, :], km, vm, MLA_SCALE).reshape(b, t, MLA_HEADS * MLA_V)
        qg5 = qg.reshape(b, t, GQA_KV_HEADS, GQA_HEADS // GQA_KV_HEADS, GQA_HEAD_DIM)
        o_g = blocked_attention(qg5, kg, vg, GQA_SCALE).reshape(b, t, GQA_HEADS * GQA_HEAD_DIM)
        return jnp.concatenate([o_m, o_g], axis=-1) @ w_out

    out_lat = heads_out(q_m, k_m_all, v_m_all, q_g, k_g_all, v_g_all)
    out_ctx = heads_out(cq_m, ck_m, cv_m, cq_g, ck_g, cv_g) if ctx_out else None
    return out_lat, out_ctx


def ssd_chunked(x, dt, bm, cm, a, init_state, want_y):
    f32 = jnp.float32
    b, t, g, r, p = x.shape
    n = bm.shape[-1]
    nc = t // SSD_CHUNK
    xdt = (x.astype(f32) * dt[..., None]).reshape(b, nc, SSD_CHUNK, g, r, p)
    da = (dt * a).reshape(b, nc, SSD_CHUNK, g, r)
    bc = bm.astype(f32).reshape(b, nc, SSD_CHUNK, g, n)
    a_cs = jnp.cumsum(da, axis=2)
    a_end = a_cs[:, :, -1]
    chunk_states = jnp.einsum('bclgn,bclgr,bclgrp->bcgrpn', bc, jnp.exp(a_end[:, :, None] - a_cs), xdt)

    def carry_state(state, inp):
        decay, new = inp
        return state * decay[..., None, None] + new, state

    final, states_in = lax.scan(carry_state, init_state, (jnp.moveaxis(jnp.exp(a_end), 1, 0), jnp.moveaxis(chunk_states, 1, 0)))
    if not want_y:
        return None, final
    cc = cm.astype(f32).reshape(b, nc, SSD_CHUNK, g, n)
    y_off = jnp.einsum('bclgn,cbgrpn,bclgr->bclgrp', cc, states_in, jnp.exp(a_cs))
    a_t = jnp.moveaxis(a_cs, 2, -1)
    seg = a_t[..., :, None] - a_t[..., None, :]
    lower = jnp.tril(jnp.ones((SSD_CHUNK, SSD_CHUNK), dtype=bool))
    decay = jnp.exp(jnp.where(lower, seg, -jnp.inf))
    cb = jnp.einsum('bclgn,bcsgn->bcgls', cc, bc)
    y_diag = jnp.einsum('bcgrls,bcsgrp->bclgrp', cb[:, :, :, None] * decay, xdt)
    return (y_diag + y_off).reshape(b, t, g, r, p), final


def ssd_inputs(u_scan, conv_w, conv_b):
    b, t, _ = u_scan.shape
    gn = SSM_GROUPS * SSM_STATE
    xbc = jax.nn.silu(depthwise_conv(u_scan[..., :SSM_XBC], conv_w, conv_b))
    xs = xbc[..., :SSM_D].reshape(b, t, SSM_GROUPS, SSM_HPG, SSM_HEAD_DIM)
    bm = xbc[..., SSM_D:SSM_D + gn].reshape(b, t, SSM_GROUPS, SSM_STATE)
    cm = xbc[..., SSM_D + gn:].reshape(b, t, SSM_GROUPS, SSM_STATE)
    dt_raw = u_scan[..., SSM_XBC:].astype(jnp.float32).reshape(b, t, SSM_GROUPS, SSM_HPG)
    return xs, bm, cm, dt_raw


def bidir_ssd(inputs, a_log, dt_bias, d_skip, inits, want_y):
    xs, bm, cm, dt_raw = inputs
    ys = []
    finals = []
    for d in range(2):
        dt = jax.nn.softplus(dt_raw + dt_bias[d].astype(jnp.float32).reshape(SSM_GROUPS, SSM_HPG))
        a = -jnp.exp(a_log[d].astype(jnp.float32)).reshape(SSM_GROUPS, SSM_HPG)
        seq = (xs, dt, bm, cm)
        if d == 1:
            seq = tuple(jnp.flip(z, axis=1) for z in seq)
        y, fin = ssd_chunked(seq[0], seq[1], seq[2], seq[3], a, inits[d], want_y)
        finals.append(fin)
        if want_y:
            ys.append(jnp.flip(y, axis=1) if d == 1 else y)
    if not want_y:
        return None, finals
    skip = (d_skip[0] + d_skip[1]).astype(jnp.float32).reshape(SSM_GROUPS, SSM_HPG, 1)
    return ys[0] + ys[1] + skip * xs.astype(jnp.float32), finals


def conformer_conv(u, dw_w, dw_b, ln_g, ln_b):
    v = u[..., :CONF_D] * jax.nn.sigmoid(u[..., CONF_D:])
    v = depthwise_conv(v, dw_w, dw_b)
    return jax.nn.silu(layer_norm(v, ln_g, ln_b))


def ssm_conv_mixer(h_lat, h_ctx, w_in, conv_w, conv_b, a_log, dt_bias, d_skip, norm_g, dw_w, dw_b, ln_g, ln_b, w_out, ctx_out):
    lo, hi = SSM_D, SSM_D + SSM_XBC + SSM_HEADS
    b = h_lat.shape[0]
    u_lat = h_lat @ w_in
    if ctx_out:
        u_ctx = h_ctx @ w_in
        ctx_scan = u_ctx[..., lo:hi]
    else:
        u_ctx = None
        ctx_scan = h_ctx @ w_in[:, lo:hi]
    zero = jnp.zeros((b, SSM_GROUPS, SSM_HPG, SSM_HEAD_DIM, SSM_STATE), jnp.float32)
    y_ctx, ctx_states = bidir_ssd(ssd_inputs(ctx_scan, conv_w, conv_b), a_log, dt_bias, d_skip, (zero, zero), ctx_out)
    y_lat, _ = bidir_ssd(ssd_inputs(u_lat[..., lo:hi], conv_w, conv_b), a_log, dt_bias, d_skip, ctx_states, True)

    def merge(u, y):
        bb, t, _ = u.shape
        gated = y.reshape(bb, t, SSM_D) * jax.nn.silu(u[..., :SSM_D].astype(jnp.float32))
        y_ssm = rms_norm(gated, norm_g).astype(u.dtype)
        y_conv = conformer_conv(u[..., hi:], dw_w, dw_b, ln_g, ln_b)
        return jnp.concatenate([y_ssm, y_conv], axis=-1) @ w_out

    out_ctx = merge(u_ctx, y_ctx) if ctx_out else None
    return merge(u_lat, y_lat), out_ctx


def moe_ffn(h, w_router, b_router, w_gate_up, b_gate_up, w_down, b_down):
    n_tok, d = h.shape
    n_assign = n_tok * MOE_TOP_K
    logits = h.astype(jnp.float32) @ w_router.astype(jnp.float32) + b_router.astype(jnp.float32)
    top_logit, top_e = lax.top_k(logits, MOE_TOP_K)
    top_w = jax.nn.softmax(top_logit, axis=-1).astype(h.dtype)
    flat_e = top_e.reshape(-1)
    flat_tok = jnp.arange(n_assign, dtype=jnp.int32) // MOE_TOP_K
    order = jnp.argsort(flat_e)
    e_sorted = flat_e[order]
    counts = jnp.zeros((N_EXPERTS,), jnp.int32).at[flat_e].add(1)
    padded = (counts + MOE_BLOCK - 1) // MOE_BLOCK * MOE_BLOCK
    start = jnp.cumsum(counts) - counts
    pend = jnp.cumsum(padded)
    pstart = pend - padded
    dest = pstart[e_sorted] + jnp.arange(n_assign, dtype=jnp.int32) - start[e_sorted]
    n_blocks = -(-n_assign // MOE_BLOCK) + N_EXPERTS
    n_rows = n_blocks * MOE_BLOCK
    row_tok = jnp.zeros((n_rows,), jnp.int32).at[dest].set(flat_tok[order])
    row_w = jnp.zeros((n_rows,), h.dtype).at[dest].set(top_w.reshape(-1)[order])
    block_start = jnp.arange(n_blocks, dtype=jnp.int32) * MOE_BLOCK
    block_expert = jnp.minimum(jnp.searchsorted(pend, block_start, side='right'), N_EXPERTS - 1)
    xs = h[row_tok].reshape(n_blocks, MOE_BLOCK, d)

    def expert_block(args):
        xb, e = args
        gu = xb @ w_gate_up[e] + b_gate_up[e]
        gate = jnp.minimum(gu[:, :MOE_FF], SWIGLU_LIMIT)
        up = jnp.clip(gu[:, MOE_FF:], -SWIGLU_LIMIT, SWIGLU_LIMIT)
        act = (up + 1.0) * (gate * jax.nn.sigmoid(SWIGLU_ALPHA * gate))
        return act @ w_down[e] + b_down[e]

    ys = lax.map(expert_block, (xs, block_expert)).reshape(n_rows, d) * row_w[:, None]
    return jnp.zeros_like(h).at[row_tok].add(ys)


def setup_inputs(seed: int = 0) -> dict:
    key = jax.random.key(seed)
    ks = iter(list(jax.random.split(key, 64)))
    f32 = jnp.float32

    def nrm(shape, scale):
        return jax.random.normal(next(ks), shape, f32) * scale

    def gain(shape):
        return 1.0 + 0.05 * jax.random.normal(next(ks), shape, f32)

    D = D_MODEL
    NA, NS = N_ATTN_LAYERS, N_SSM_LAYERS
    a_init = jax.random.uniform(next(ks), (NS, 2, SSM_HEADS), f32, 1.0, 16.0)
    dt_init = jnp.exp(jax.random.uniform(next(ks), (NS, 2, SSM_HEADS), f32, np.log(1e-3), np.log(1e-1)))
    return {
        'x': nrm((BATCH, SEQ, D), 1.0),
        'c': nrm((BATCH, D), 1.0),
        'ctx': nrm((BATCH, CTX_LEN, D), 1.0),
        'c_ctx': nrm((D,), 1.0),
        'w_mod': nrm((DEPTH, D, 6 * D), 0.5 * D ** -0.5),
        'b_mod': nrm((DEPTH, 6 * D), 0.02),
        'norm_g': gain((DEPTH, 2, D)),
        'attn_w_in': nrm((NA, D, ATTN_IN), D ** -0.5),
        'mla_g_cq': gain((NA, MLA_Q_LORA)),
        'mla_w_uq': nrm((NA, MLA_Q_LORA, MLA_HEADS * (MLA_NOPE + MLA_ROPE)), MLA_Q_LORA ** -0.5),
        'mla_g_ckv': gain((NA, MLA_KV_LORA)),
        'mla_w_ukv': nrm((NA, MLA_KV_LORA, MLA_HEADS * (MLA_NOPE + MLA_V)), MLA_KV_LORA ** -0.5),
        'gqa_g_q': gain((NA, GQA_HEAD_DIM)),
        'gqa_g_k': gain((NA, GQA_HEAD_DIM)),
        'attn_w_out': nrm((NA, ATTN_OUT, D), ATTN_OUT ** -0.5),
        'ssm_w_in': nrm((NS, D, SSM_IN), D ** -0.5),
        'ssm_conv_w': nrm((NS, SSM_CONV, SSM_XBC), SSM_CONV ** -0.5),
        'ssm_conv_b': nrm((NS, SSM_XBC), 0.02),
        'ssm_a_log': jnp.log(a_init),
        'ssm_dt_bias': dt_init + jnp.log(-jnp.expm1(-dt_init)),
        'ssm_d': gain((NS, 2, SSM_HEADS)),
        'ssm_norm_g': gain((NS, SSM_D)),
        'conf_dw_w': nrm((NS, CONF_K, CONF_D), CONF_K ** -0.5),
        'conf_dw_b': nrm((NS, CONF_D), 0.02),
        'conf_ln_g': gain((NS, CONF_D)),
        'conf_ln_b': nrm((NS, CONF_D), 0.02),
        'ssm_w_out': nrm((NS, SSM_OUT, D), SSM_OUT ** -0.5),
        'moe_w_router': nrm((DEPTH, D, N_EXPERTS), D ** -0.5),
        'moe_b_router': nrm((DEPTH, N_EXPERTS), 0.01),
        'moe_w_gate_up': nrm((DEPTH, N_EXPERTS, D, 2 * MOE_FF), D ** -0.5),
        'moe_b_gate_up': nrm((DEPTH, N_EXPERTS, 2 * MOE_FF), 0.02),
        'moe_w_down': nrm((DEPTH, N_EXPERTS, MOE_FF, D), MOE_FF ** -0.5),
        'moe_b_down': nrm((DEPTH, N_EXPERTS, D), 0.02),
        'final_g': gain((D,)),
    }


def reference(x, c, ctx, c_ctx, w_mod, b_mod, norm_g, attn_w_in, mla_g_cq, mla_w_uq, mla_g_ckv, mla_w_ukv, gqa_g_q, gqa_g_k, attn_w_out, ssm_w_in, ssm_conv_w, ssm_conv_b, ssm_a_log, ssm_dt_bias, ssm_d, ssm_norm_g, conf_dw_w, conf_dw_b, conf_ln_g, conf_ln_b, ssm_w_out, moe_w_router, moe_b_router, moe_w_gate_up, moe_b_gate_up, moe_w_down, moe_b_down, final_g):
    b, s, d = x.shape
    silu_c = jax.nn.silu(c)
    silu_cc = jax.nn.silu(c_ctx)
    for i in range(DEPTH):
        ctx_out = i < DEPTH - 1
        j = i // 2
        mod = (silu_c @ w_mod[i] + b_mod[i])[:, None, :]
        sh1, sc1, g1, sh2, sc2, g2 = jnp.split(mod, 6, axis=-1)
        n_cm = 6 if ctx_out else 2
        mod_c = silu_cc @ w_mod[i][:, :n_cm * d] + b_mod[i][:n_cm * d]
        cmods = jnp.split(mod_c, n_cm, axis=-1)
        h_lat = modulate(rms_norm(x, norm_g[i, 0]), sh1, sc1)
        h_ctx = modulate(rms_norm(ctx, norm_g[i, 0]), cmods[0], cmods[1])
        if i % 2 == 0:
            o_lat, o_ctx = attention_mixer(h_lat, h_ctx, attn_w_in[j], mla_g_cq[j], mla_w_uq[j], mla_g_ckv[j], mla_w_ukv[j], gqa_g_q[j], gqa_g_k[j], attn_w_out[j], ctx_out)
        else:
            o_lat, o_ctx = ssm_conv_mixer(h_lat, h_ctx, ssm_w_in[j], ssm_conv_w[j], ssm_conv_b[j], ssm_a_log[j], ssm_dt_bias[j], ssm_d[j], ssm_norm_g[j], conf_dw_w[j], conf_dw_b[j], conf_ln_g[j], conf_ln_b[j], ssm_w_out[j], ctx_out)
        x = x + g1 * o_lat
        h_lat = modulate(rms_norm(x, norm_g[i, 1]), sh2, sc2)
        if ctx_out:
            ctx = ctx + cmods[2] * o_ctx
            h_ctx = modulate(rms_norm(ctx, norm_g[i, 1]), cmods[3], cmods[4])
            tokens = jnp.concatenate([h_lat.reshape(-1, d), h_ctx.reshape(-1, d)], axis=0)
            f = moe_ffn(tokens, moe_w_router[i], moe_b_router[i], moe_w_gate_up[i], moe_b_gate_up[i], moe_w_down[i], moe_b_down[i])
            x = x + g2 * f[:b * s].reshape(b, s, d)
            ctx = ctx + cmods[5] * f[b * s:].reshape(ctx.shape)
        else:
            f = moe_ffn(h_lat.reshape(-1, d), moe_w_router[i], moe_b_router[i], moe_w_gate_up[i], moe_b_gate_up[i], moe_w_down[i], moe_b_down[i])
            x = x + g2 * f.reshape(b, s, d)
    return rms_norm(x, final_g)
```

```cpp
#include <hip/hip_runtime.h>
#include <cstdio>
#include <cstdint>

#define LAS __attribute__((address_space(3)))
#define GAS __attribute__((address_space(1)))
typedef unsigned short bf16_t;
typedef short bf16x8 __attribute__((ext_vector_type(8)));
typedef short s16x4 __attribute__((ext_vector_type(4)));
typedef float f32x2 __attribute__((ext_vector_type(2)));
typedef float f32x4 __attribute__((ext_vector_type(4)));
typedef float f32x16 __attribute__((ext_vector_type(16)));
typedef unsigned u32x2 __attribute__((ext_vector_type(2)));
typedef unsigned u32x4 __attribute__((ext_vector_type(4)));
typedef __bf16 bf16x2_t __attribute__((ext_vector_type(2)));

constexpr int D = 1024, NBATCH = 4, SEQ = 4096, CTXL = 256, TPB = SEQ + CTXL  , MR = NBATCH * TPB  ;
constexpr float EPS = 1e-6f;
constexpr int ATTN_IN = 1184, ATTN_INP = 1280, UPK = 384, UPN = 1792;
constexpr int SSM_IN = 4624, SSM_INP = 4864, XBC = 1536;
constexpr int NE = 32, TOPK = 4, MAXROWS = 77824;
constexpr int NCHUNK = 34;
constexpr float LOG2E = 1.4426950408889634f;
constexpr float C2M = 0.10206207261596577f * LOG2E;
constexpr float C2G = 0.125f * LOG2E;

constexpr size_t MiB = 1u << 20;
constexpr size_t WS_CTL = 0, CTL_ZERO_BYTES = 1 * MiB;
constexpr size_t WS_MOD = 1 * MiB;
constexpr size_t WS_ROPEM = 2 * MiB;
constexpr size_t WS_ROPEG = 3 * MiB;
constexpr size_t WS_WAIN = 4 * MiB;
constexpr size_t WS_WUP = 7 * MiB;
constexpr size_t WS_WAOUT = 9 * MiB;
constexpr size_t WS_WSIN = 11 * MiB;
constexpr size_t WS_WSOUT = 21 * MiB;
constexpr size_t WS_WGU = 32 * MiB;
constexpr size_t WS_WDN = 160 * MiB;
constexpr size_t WS_H = 224 * MiB;
constexpr size_t WS_X1 = 260 * MiB;
constexpr size_t WS_X2 = 332 * MiB;
constexpr size_t WS_O = 404 * MiB;
constexpr size_t WS_U0 = 440 * MiB;
constexpr size_t WS_Z = WS_U0, WS_V = WS_U0 + 36 * MiB;
constexpr size_t WS_CQKV = 528 * MiB;
constexpr size_t WS_QM = 542 * MiB, WS_KM = 568 * MiB;
constexpr size_t WS_VM = 594 * MiB, WS_QG = 612 * MiB;
constexpr size_t WS_KG = 630 * MiB, WS_VG = 636 * MiB;
constexpr size_t WS_TOPE = 642 * MiB, WS_TOPP = 643 * MiB, WS_TOPW = 644 * MiB;
constexpr size_t WS_ACT = 645 * MiB;
constexpr size_t WS_YS = 721 * MiB;
constexpr size_t WS_XBCRAW = 873 * MiB;
constexpr size_t WS_XBC = 925 * MiB;
constexpr size_t WS_DTRAW = 977 * MiB;
constexpr size_t WS_DT = 979 * MiB;
constexpr size_t WS_CHST = 982 * MiB;
constexpr size_t WS_STIN = 1118 * MiB;
constexpr size_t WS_AEND = 1186 * MiB;
constexpr size_t WS_A3 = 1187 * MiB;
constexpr size_t WS_X8 = 1257 * MiB;
constexpr size_t WS_END = 1801 * MiB;
constexpr int CW_BAR = 4096;
constexpr int CW_RDY = 32768;
constexpr int CW_RDY2 = 32768 + 8192;
constexpr int CW_CNT0 = 8192, CW_CNT1 = 8192 + 4096;

constexpr int NWAVES = 8, NTHREADS = 512;
constexpr int LDS_BYTES = 163840;
constexpr int MISC_OFF = 163840 - 256;

#define MK_FP8 1
constexpr float FP8_SW = 64.f, FP8_SH = 16.f, FP8_SA = 4.f, FP8_SY = 16.f;
constexpr int E8_G1 = 0x7a7a7a7a, E8_G2 = 0x7b7b7b7b;
__device__ __forceinline__ unsigned cvtpk(float lo, float hi) { f32x2 v = {lo, hi}; bf16x2_t b = __builtin_convertvector(v, bf16x2_t); return __builtin_bit_cast(unsigned, b); }
__device__ __forceinline__ float clamp448(float x) { return __builtin_amdgcn_fmed3f(x, -448.f, 448.f); }
__device__ __forceinline__ unsigned pk4_fp8(float a, float b, float c, float d) {
    int w = __builtin_amdgcn_cvt_pk_fp8_f32(clamp448(a), clamp448(b), 0, false); w = __builtin_amdgcn_cvt_pk_fp8_f32(clamp448(c), clamp448(d), w, true); return (unsigned)w; }
__device__ __forceinline__ unsigned pk4_fp8_nc(float a, float b, float c, float d) {
    int w = __builtin_amdgcn_cvt_pk_fp8_f32(a, b, 0, false); w = __builtin_amdgcn_cvt_pk_fp8_f32(c, d, w, true); return (unsigned)w; }
__device__ __forceinline__ float bf2f(unsigned short b) { return __uint_as_float(((unsigned)b) << 16); }
__device__ __forceinline__ float bflo(unsigned w) { return __uint_as_float(w << 16); }
__device__ __forceinline__ float bfhi(unsigned w) { return __uint_as_float(w & 0xffff0000u); }
__device__ __forceinline__ float wave_sum(float v) {
#pragma unroll
    for (int o = 1; o < 64; o <<= 1) v += __shfl_xor(v, o);
    return v;
}
__device__ __forceinline__ float sigmoid_f(float x) { return __builtin_amdgcn_rcpf(1.0f + __builtin_amdgcn_exp2f(x * -LOG2E)); }
__device__ __forceinline__ float silu_f(float x) { return x * sigmoid_f(x); }
#define LDS_WAIT() asm volatile("s_waitcnt lgkmcnt(0)" ::: "memory")
#define VM_WAIT() asm volatile("s_waitcnt vmcnt(0)" ::: "memory")

#define XB_TMO      128
#define XB_XCNT(j)  (256  + 64 * (j))
#define XB_XSUB(j)  (1280 + 64 * (j))
#define XB_XGEN(j)  (2304 + 64 * (j))
#define XB_TOP      3328
#define XB_TOPGEN   3392
#define XCD_BAR_WORDS 3456
#define XB_SPIN_CAP (1u << 18)
__device__ __forceinline__ unsigned xb_ld(unsigned* p)              { return __hip_atomic_load(p, __ATOMIC_RELAXED, __HIP_MEMORY_SCOPE_AGENT); }
__device__ __forceinline__ unsigned xb_add(unsigned* p, unsigned v) { return __hip_atomic_fetch_add(p, v, __ATOMIC_RELAXED, __HIP_MEMORY_SCOPE_AGENT); }
__device__ __forceinline__ unsigned xb_xcc_id() { return (unsigned)__builtin_amdgcn_s_getreg((3 << 11) | 20) & 0xFu; }
#define XB_SPIN(cond, bar) do { unsigned _sp = 0; while (cond) { __builtin_amdgcn_s_sleep(1); \
    if ((++_sp & 255u) == 0u) { if (xb_ld(&(bar)[XB_TMO])) break; if (_sp > XB_SPIN_CAP) { atomicAdd(&(bar)[XB_TMO], 1u); break; } } } } while (0)
struct XcdBarrier { unsigned* bar; unsigned x; volatile LAS unsigned* st; };
__device__ __forceinline__ XcdBarrier xcd_barrier_post(unsigned* bar, volatile LAS unsigned* st) {
    XcdBarrier b; b.bar = bar; b.x = xb_xcc_id(); b.st = st;
    if (threadIdx.x == 0) (void)xb_add(&bar[XB_XCNT(b.x)], 1u);
    return b;
}
__device__ __forceinline__ void xcd_barrier_complete(unsigned* bar, unsigned x, unsigned& nloc, unsigned& nx) {
    const unsigned G = gridDim.x * gridDim.y * gridDim.z;
    unsigned sum, cnt, mine, sp = 0u;
    for (;;) {
        sum = 0u; cnt = 0u; mine = 0u;
#pragma unroll
        for (unsigned j = 0; j < 16; ++j) { const unsigned c = xb_ld(&bar[XB_XCNT(j)]); sum += c; cnt += (c > 0u) ? 1u : 0u; mine = (j == x) ? c : mine; }
        if (sum == G) break;
        __builtin_amdgcn_s_sleep(1);
        if ((++sp & 255u) == 0u) { if (xb_ld(&bar[XB_TMO])) break; if (sp > XB_SPIN_CAP) { atomicAdd(&bar[XB_TMO], 1u); break; } }
    }
    nloc = mine > 0u ? mine : 1u; nx = cnt > 0u ? cnt : 1u;
}
__device__ __forceinline__ void xcd_barrier(const XcdBarrier& b) {
    asm volatile("s_waitcnt vmcnt(0)" ::: "memory");
    __syncthreads();
    if (threadIdx.x == 0) {
        unsigned* bar = b.bar;
        __builtin_amdgcn_s_waitcnt(0);
        unsigned nloc = b.st[0], nx = b.st[1];
        if (nloc == 0u) { xcd_barrier_complete(bar, b.x, nloc, nx); b.st[0] = nloc; b.st[1] = nx; }
        const unsigned old = xb_add(&bar[XB_XSUB(b.x)], 1u);
        const unsigned gen = old / nloc;
        if (old + 1u == (gen + 1u) * nloc) {
            __builtin_amdgcn_fence(__ATOMIC_RELEASE, "agent");
            asm volatile("s_waitcnt vmcnt(0)" ::: "memory");
            const unsigned og = xb_add(&bar[XB_TOP], 1u);
            const unsigned tg = og / nx;
            if (og + 1u == (tg + 1u) * nx) xb_add(&bar[XB_TOPGEN], 1u);
            else XB_SPIN(xb_ld(&bar[XB_TOPGEN]) == tg, bar);
            __builtin_amdgcn_fence(__ATOMIC_ACQUIRE, "agent");
            xb_add(&bar[XB_XGEN(b.x)], 1u);
            asm volatile("s_waitcnt vmcnt(0)" ::: "memory");
        } else {
            XB_SPIN(xb_ld(&bar[XB_XGEN(b.x)]) == gen, bar);
            __builtin_amdgcn_fence(__ATOMIC_ACQUIRE, "agent");
            asm volatile("s_waitcnt vmcnt(0)" ::: "memory");
        }
    }
    __syncthreads();
}

__device__ __forceinline__ void store_wt16(void* p, u32x4 v) { asm volatile("global_store_dwordx4 %0, %1, off sc1\n\ts_nop 1" :: "v"(p), "v"(v) : "memory"); }
__device__ __forceinline__ void wait_rows_ready(unsigned* rdy, int r0, int r1, unsigned want) {
    if (r1 <= r0) return;
    for (int t = r0 >> 8; t <= (r1 - 1) >> 8; ++t) { unsigned sp = 0u; while (xb_ld(rdy + 64 * t) < want) { __builtin_amdgcn_s_sleep(1); if (++sp > (1u << 21)) break; } }
    __builtin_amdgcn_fence(__ATOMIC_ACQUIRE, "agent");
}

struct Args { const float* in[34]; float* out; unsigned char* ws; int ph_lo, ph_hi; };
struct Frame {
    LAS unsigned char* lds;
    unsigned char* ws;
    unsigned* ctl;
    int tid, lane, wave, G, bid;
    const float* x; const float* ctx;
};
enum { I_X = 0, I_C, I_CTX, I_CCTX, I_WMOD, I_BMOD, I_NORMG, I_AWIN, I_GCQ, I_WUQ, I_GCKV, I_WUKV, I_GQ, I_GK, I_AWOUT, I_SWIN, I_SCONVW, I_SCONVB, I_ALOG, I_DTBIAS, I_SD, I_SNORMG,
       I_CDWW, I_CDWB, I_CLNG, I_CLNB, I_SWOUT, I_WROUTER, I_BROUTER, I_WGU, I_BGU, I_WDN, I_BDN, I_FINALG };

__device__ __forceinline__ int fresh_tid(int wave) { int l; asm volatile("v_mbcnt_lo_u32_b32 %0, -1, 0\n\tv_mbcnt_hi_u32_b32 %0, -1, %0" : "=v"(l)); return wave * 64 + l; }
__device__ __forceinline__ const float* inp(int i) {
    unsigned long long p; asm volatile("s_load_dwordx2 %0, %1, %2\n\ts_waitcnt lgkmcnt(0)" : "=s"(p) : "s"(__builtin_amdgcn_kernarg_segment_ptr()), "n"(i * 8));
    return (const float*)(GAS const float*)p; }
__device__ __forceinline__ const float* src_row(const Frame& F, int r) {
    const int b = r / TPB, tp = r - b * TPB;
    return tp < CTXL ? F.ctx + ((size_t)b * CTXL + tp) * D : F.x + ((size_t)b * SEQ + (tp - CTXL)) * D;
}
__device__ __forceinline__ const float* mod_vec(const Frame& F, int layer, int r, int k) {
    const int b = r / TPB, tp = r - b * TPB; const int v = tp < CTXL ? 4 : b;
    return (const float*)(F.ws + WS_MOD) + ((size_t)(layer * 5 + v) * 6 + k) * D;
}
#ifndef MK_DENSE_SP2
#define MK_DENSE_SP2 1
#endif
namespace pg8 {
constexpr int BM = 256, BK = 64, HALF = 128, HTB = HALF * BK * 2, STAGE_BYTES = 8 * HTB;
__host__ __device__ __forceinline__ int lds_byte(int r, int c) { const int st = (r >> 4) * 2 + (c >> 5), rr = r & 15, cc = c & 31, ob = rr * 64 + cc * 2; return st * 1024 + (ob ^ (((ob >> 9) & 1) << 5)); }
__host__ __device__ __forceinline__ void stage_rc(int b, int& R, int& C) { const int st = b / 1024, sb = b % 1024, swz = sb ^ (((sb >> 9) & 1) << 5); R = (st >> 1) * 16 + swz / 64; C = (st & 1) * 32 + (swz % 64) / 2; }
__host__ __device__ __forceinline__ int perm32(int rho) { const int n = rho >> 4, i = rho & 15; return 8 * (i >> 2) + 4 * n + (i & 3); }

__device__ __forceinline__ const char* uni64(const char* p) {
    const unsigned lo = __builtin_amdgcn_readfirstlane((unsigned)(uintptr_t)p), hi = __builtin_amdgcn_readfirstlane((unsigned)((uintptr_t)p >> 32)); return (const char*)(((uintptr_t)hi << 32) | (uintptr_t)lo); }
__device__ __forceinline__ int pg8_lane() { int l; asm volatile("v_mbcnt_lo_u32_b32 %0, -1, 0\n\tv_mbcnt_hi_u32_b32 %0, -1, %0" : "=v"(l)); return l; }
struct GUnit {
    const char* A;
    const char* B0; const char* B1;
    const int* rows; int nrows;
    int row0;
    int col0, col1;
    int e;
};

template <class Epi, class Sched, bool GATHER, bool FP8 = false, int SCB = 0x7f7f7f7f, int SCA = 0x7f7f7f7f, bool SP2 = (MK_DENSE_SP2 != 0), bool ALIGN_EPI = true>
__device__ __forceinline__ void gemm_phase(LAS unsigned char* lds, const int KB, const Sched& S, const Epi& E, const int tid) {
    const int wid = __builtin_amdgcn_readfirstlane(tid >> 6), lane = tid & 63, wr = wid >> 2, wc = wid & 3, fr = lane & 15, fq = lane >> 4;
    const int nt = KB / 128;
    unsigned voffA, voffB;
    { int R, C; stage_rc(tid * 16, R, C); voffA = (unsigned)(R * KB + C * 2); voffB = (unsigned)(((R & ~31) + perm32(R & 31)) * KB + C * 2); }
    const size_t hoff = (size_t)HALF * KB, ioff = (size_t)64 * KB;
    const size_t kstep = (size_t)(BK * 2);
    const unsigned ldsw = (unsigned)wid * 1024u;
    const int aoff = lds_byte(wr * 64 + fr, fq * 8), boff = lds_byte(wc * 32 + fr, fq * 8);
    constexpr int KSL = 1024;
#define PG8_SA(b, h) (((b) * 2 + (h)) * HTB)
#define PG8_SB(b, h) ((4 + (b) * 2 + (h)) * HTB)
#define PG8_STAGE(bufoff, gbase, voff) do { _Pragma("unroll") for (int _i = 0; _i < 2; ++_i) { const char* _ub = uni64((const char*)(gbase) + _i * ioff); \
        unsigned _vo = (voff); asm volatile("" : "+v"(_vo));        \
        __builtin_amdgcn_global_load_lds((const unsigned*)(_ub + _vo), (LAS unsigned*)(lds + (bufoff) + ldsw + _i * 8192), 16, 0, 0); } } while (0)
#define PG8_LDA(dst, b, h) do { _Pragma("unroll") for (int m = 0; m < 4; ++m) _Pragma("unroll") for (int k = 0; k < 2; ++k) dst[m][k] = *(const LAS bf16x8*)(lds + PG8_SA(b, h) + aoff + m * 2048 + k * KSL); } while (0)
#define PG8_LDB(dst, b, h) do { _Pragma("unroll") for (int n = 0; n < 2; ++n) _Pragma("unroll") for (int k = 0; k < 2; ++k) dst[n][k] = *(const LAS bf16x8*)(lds + PG8_SB(b, h) + boff + n * 2048 + k * KSL); } while (0)
#define PG8_MMA(ai, bj, At, Bt) do { __builtin_amdgcn_s_setprio(1); _Pragma("unroll") for (int m = 0; m < 4; ++m) _Pragma("unroll") for (int n = 0; n < 2; ++n) { \
        if (FP8) { typedef int v4i_t __attribute__((ext_vector_type(4))); typedef int v8i_t __attribute__((ext_vector_type(8))); \
            const v4i_t b0_ = __builtin_bit_cast(v4i_t, Bt[n][0]), b1_ = __builtin_bit_cast(v4i_t, Bt[n][1]), a0_ = __builtin_bit_cast(v4i_t, At[m][0]), a1_ = __builtin_bit_cast(v4i_t, At[m][1]); \
            acc[ai][bj][m][n] = __builtin_amdgcn_mfma_scale_f32_16x16x128_f8f6f4((v8i_t){b0_[0], b0_[1], b0_[2], b0_[3], b1_[0], b1_[1], b1_[2], b1_[3]}, (v8i_t){a0_[0], a0_[1], a0_[2], a0_[3], a1_[0], a1_[1], a1_[2], a1_[3]}, acc[ai][bj][m][n], 0, 0, 0, SCB, 0, SCA); } \
        else { _Pragma("unroll") for (int k = 0; k < 2; ++k) acc[ai][bj][m][n] = __builtin_amdgcn_mfma_f32_16x16x32_bf16(Bt[n][k], At[m][k], acc[ai][bj][m][n], 0, 0, 0); } } \
        __builtin_amdgcn_s_setprio(0); } while (0)
#define PG8_WAIT_V(n) asm volatile("s_waitcnt vmcnt(" #n ")" ::: "memory")
#define PG8_WAIT_L(n) asm volatile("s_waitcnt lgkmcnt(" #n ")" ::: "memory")
#define PG8_BAR __builtin_amdgcn_s_barrier()
#define PG8_SCHED __builtin_amdgcn_sched_barrier(0)
#define PG8_INIT(u) do { const int fq3 = pg8_lane() >> 4; f32x4 _bi[2][2]; E.init(_bi, (u), wc, fq3); \
        _Pragma("unroll") for (int a = 0; a < 2; ++a) _Pragma("unroll") for (int b = 0; b < 2; ++b) _Pragma("unroll") for (int m = 0; m < 4; ++m) _Pragma("unroll") for (int n = 0; n < 2; ++n) acc[a][b][m][n] = _bi[b][n]; } while (0)
    GUnit cur, nxt; int ui = 0;
    if (!S.next(0, cur)) return;
    f32x4 acc[2][2][4][2];
    PG8_INIT(cur);
    bf16x8 At[4][2], B0[2][2], B1[2][2];
    static_assert(!GATHER, "row gather was removed: the MoE operands live in per-expert slot regions");
    const char* cA = cur.A; const char* cB0 = cur.B0; const char* cB1 = cur.B1;
    if constexpr (SP2) {
        PG8_STAGE(PG8_SB(0, 0), cB0, voffB); PG8_STAGE(PG8_SB(0, 1), cB1, voffB); PG8_STAGE(PG8_SA(0, 0), cA, voffA); PG8_STAGE(PG8_SA(0, 1), cA + hoff, voffA);
        if (wr == 1) PG8_BAR;
        PG8_WAIT_V(2); PG8_BAR;
        PG8_STAGE(PG8_SB(1, 0), cB0 + kstep, voffB); PG8_STAGE(PG8_SA(1, 0), cA + kstep, voffA); PG8_STAGE(PG8_SB(1, 1), cB1 + kstep, voffB);
        PG8_WAIT_V(6); PG8_BAR;
    } else {
    PG8_STAGE(PG8_SB(0, 0), cB0, voffB); PG8_STAGE(PG8_SA(0, 0), cA, voffA); PG8_STAGE(PG8_SB(0, 1), cB1, voffB); PG8_STAGE(PG8_SA(0, 1), cA + hoff, voffA);
    if (wr == 1) PG8_BAR;
    PG8_WAIT_V(4); PG8_BAR;
    PG8_STAGE(PG8_SB(1, 0), cB0 + kstep, voffB); PG8_STAGE(PG8_SA(1, 0), cA + kstep, voffA); PG8_STAGE(PG8_SB(1, 1), cB1 + kstep, voffB);
    PG8_WAIT_V(6); PG8_BAR;
    }
    for (;;) {
        const bool has_next = S.next(ui + 1, nxt);
        const char* nA = has_next ? nxt.A : cA; const char* nB0 = has_next ? nxt.B0 : cB0; const char* nB1 = has_next ? nxt.B1 : cB1;
#pragma unroll 1
        for (int t = 0; t < nt; t += 2) {
            const bool last = (t == nt - 2);
            const char* a1 = cA + (size_t)(t + 1) * kstep;
            const char* a2 = last ? nA : cA + (size_t)(t + 2) * kstep;
            const char* b20 = last ? nB0 : cB0 + (size_t)(t + 2) * kstep; const char* b21 = last ? nB1 : cB1 + (size_t)(t + 2) * kstep;
            const char* a3 = a2 + kstep; const char* b30 = b20 + kstep; const char* b31 = b21 + kstep;
            if constexpr (SP2) {
            PG8_LDB(B0, 0, 0); PG8_LDB(B1, 0, 1); PG8_SCHED; PG8_LDA(At, 0, 0); PG8_STAGE(PG8_SA(1, 1), a1 + hoff, voffA);
            PG8_WAIT_V(8); PG8_WAIT_L(0); PG8_BAR; PG8_MMA(0, 0, At, B0); PG8_MMA(0, 1, At, B1); PG8_BAR; PG8_SCHED;
            PG8_LDA(At, 0, 1); PG8_STAGE(PG8_SB(0, 0), b20, voffB); PG8_STAGE(PG8_SB(0, 1), b21, voffB); PG8_STAGE(PG8_SA(0, 0), a2, voffA);
            PG8_WAIT_V(8); PG8_WAIT_L(0); PG8_BAR; PG8_MMA(1, 0, At, B0); PG8_MMA(1, 1, At, B1); PG8_BAR; PG8_SCHED;
            PG8_LDB(B0, 1, 0); PG8_LDB(B1, 1, 1); PG8_SCHED; PG8_LDA(At, 1, 0); PG8_STAGE(PG8_SA(0, 1), a2 + hoff, voffA);
            PG8_WAIT_V(8); PG8_WAIT_L(0); PG8_BAR; PG8_MMA(0, 0, At, B0); PG8_MMA(0, 1, At, B1); PG8_BAR; PG8_SCHED;
            PG8_LDA(At, 1, 1); PG8_STAGE(PG8_SB(1, 0), b30, voffB); PG8_STAGE(PG8_SB(1, 1), b31, voffB); PG8_STAGE(PG8_SA(1, 0), a3, voffA);
            PG8_WAIT_V(8); PG8_WAIT_L(0); PG8_BAR; PG8_MMA(1, 0, At, B0); PG8_MMA(1, 1, At, B1); PG8_BAR; PG8_SCHED;
            } else {
            PG8_LDB(B0, 0, 0); PG8_SCHED; PG8_LDA(At, 0, 0); PG8_STAGE(PG8_SA(1, 1), a1 + hoff, voffA);
            PG8_WAIT_L(8); PG8_BAR; PG8_WAIT_L(0); PG8_MMA(0, 0, At, B0); PG8_BAR; PG8_SCHED;
            PG8_LDB(B1, 0, 1); PG8_STAGE(PG8_SB(0, 0), b20, voffB);
            PG8_BAR; PG8_WAIT_L(0); PG8_MMA(0, 1, At, B1); PG8_BAR;
            PG8_LDA(At, 0, 1); PG8_STAGE(PG8_SA(0, 0), a2, voffA);
            PG8_BAR; PG8_WAIT_L(0); PG8_MMA(1, 0, At, B0); PG8_BAR; PG8_SCHED;
            PG8_STAGE(PG8_SB(0, 1), b21, voffB);
            PG8_WAIT_V(6); PG8_BAR; PG8_MMA(1, 1, At, B1); PG8_BAR;
            PG8_LDB(B0, 1, 0); PG8_SCHED; PG8_LDA(At, 1, 0); PG8_STAGE(PG8_SA(0, 1), a2 + hoff, voffA);
            PG8_WAIT_L(8); PG8_BAR; PG8_WAIT_L(0); PG8_MMA(0, 0, At, B0); PG8_BAR; PG8_SCHED;
            PG8_LDB(B1, 1, 1); PG8_STAGE(PG8_SB(1, 0), b30, voffB);
            PG8_BAR; PG8_WAIT_L(0); PG8_MMA(0, 1, At, B1); PG8_BAR;
            PG8_LDA(At, 1, 1); PG8_STAGE(PG8_SA(1, 0), a3, voffA);
            PG8_BAR; PG8_WAIT_L(0); PG8_MMA(1, 0, At, B0); PG8_BAR; PG8_SCHED;
            PG8_STAGE(PG8_SB(1, 1), b31, voffB);
            PG8_WAIT_V(6); PG8_BAR; PG8_MMA(1, 1, At, B1); PG8_BAR;
            }
        }
        if constexpr (ALIGN_EPI) { if (wr == 0) PG8_BAR; }
        { const int l2_ = pg8_lane(); const int fr2 = l2_ & 15, fq2 = l2_ >> 4;
          E(acc, cur, wr, wc, fr2, fq2); }
        if constexpr (Epi::PUB) {
            static_assert(ALIGN_EPI, "the publish barrier needs the two wave halves aligned");
            unsigned* const rf_ = E.ready_flag(cur);
            if (rf_ != nullptr) { PG8_WAIT_V(0); PG8_BAR; if (wid == 0 && pg8_lane() == 0) (void)xb_add(rf_, 1u); }
        }
        if (!has_next) break;
        PG8_INIT(nxt);
        cur = nxt; cA = nA; cB0 = nB0; cB1 = nB1; ++ui;
        if constexpr (ALIGN_EPI) { if (wr == 1) PG8_BAR; }
    }
    PG8_WAIT_V(0);
    if constexpr (!ALIGN_EPI) { if (wr == 0) PG8_BAR; }
    PG8_BAR;
#undef PG8_INIT
#undef PG8_SA
#undef PG8_SB
#undef PG8_STAGE
#undef PG8_LDA
#undef PG8_LDB
#undef PG8_MMA
#undef PG8_WAIT_V
#undef PG8_WAIT_L
#undef PG8_BAR
#undef PG8_SCHED
}
}
__device__ __forceinline__ void tr_item(const float* W, int ldn, int k0, int n0, int nvalid, bf16_t* WT, int ldk, int drow0, int dk0, LAS float* scr, int lane) {
#pragma unroll 8
    for (int i = 0; i < 32; ++i) { const int kk = 2 * i + (lane >> 5); const int nn = lane & 31; scr[kk * 33 + nn] = (nn < nvalid) ? W[(size_t)(k0 + kk) * ldn + n0 + nn] : 0.f; }
    LDS_WAIT(); asm volatile("" ::: "memory");
    const int c = lane & 7;
#pragma unroll
    for (int j = 0; j < 4; ++j) { const int n = (lane >> 3) + 8 * j; const LAS float* s = scr + (8 * c) * 33 + n;
        u32x4 o; o.x = cvtpk(s[0 * 33], s[1 * 33]); o.y = cvtpk(s[2 * 33], s[3 * 33]); o.z = cvtpk(s[4 * 33], s[5 * 33]); o.w = cvtpk(s[6 * 33], s[7 * 33]);
        if (n < nvalid) *(u32x4*)(WT + (size_t)(drow0 + n) * ldk + dk0 + k0 + 8 * c) = o; }
    LDS_WAIT(); asm volatile("" ::: "memory");
}
__device__ __forceinline__ void tr_item8(const float* W, int ldn, int k0, int n0, unsigned char* WT, int ldk, int drow0, float scale, LAS float* scr, int lane) {
#pragma unroll 8
    for (int i = 0; i < 64; ++i) { const int kk = 2 * i + (lane >> 5); const int nn = lane & 31; scr[kk * 33 + nn] = W[(size_t)(k0 + kk) * ldn + n0 + nn]; }
    LDS_WAIT(); asm volatile("" ::: "memory");
#pragma unroll
    for (int j = 0; j < 4; ++j) { const int q = lane + 64 * j, n = q >> 3, c = q & 7; const LAS float* s = scr + (16 * c) * 33 + n;
        u32x4 o; o.x = pk4_fp8(s[0 * 33] * scale, s[1 * 33] * scale, s[2 * 33] * scale, s[3 * 33] * scale); o.y = pk4_fp8(s[4 * 33] * scale, s[5 * 33] * scale, s[6 * 33] * scale, s[7 * 33] * scale);
        o.z = pk4_fp8(s[8 * 33] * scale, s[9 * 33] * scale, s[10 * 33] * scale, s[11 * 33] * scale); o.w = pk4_fp8(s[12 * 33] * scale, s[13 * 33] * scale, s[14 * 33] * scale, s[15 * 33] * scale);
        *(u32x4*)(WT + (size_t)(drow0 + n) * ldk + k0 + 16 * c) = o; }
    LDS_WAIT(); asm volatile("" ::: "memory");
}
__device__ __forceinline__ void zero_rect(const Frame& F, bf16_t* base, int ldk, int row0, int nrows, int k0, int kw) {
    const int per = kw / 8; const int total = nrows * per;
    for (int i = F.bid * NTHREADS + F.tid; i < total; i += F.G * NTHREADS) { const int r = i / per, c = i % per; *(u32x4*)(base + (size_t)(row0 + r) * ldk + k0 + c * 8) = (u32x4){0u, 0u, 0u, 0u}; }
}

__device__ __forceinline__ void p0_prologue(const Frame& F) {
    {
        const float* pc_ = inp(I_C); const float* pcc_ = inp(I_CCTX); const float* pwm_ = inp(I_WMOD); const float* pbm_ = inp(I_BMOD);
        LAS float* sl = (LAS float*)F.lds;
        LAS float* red = (LAS float*)(F.lds + 5 * 1024 * 4);
        bool staged = false;
        for (int task = F.bid; task < 2 * 96; task += F.G) {
            const int layer = task / 96, jb = task % 96;
            if (!staged) {
                for (int i = F.tid; i < 5 * 1024; i += NTHREADS) { const int v = i >> 10, c = i & 1023; const float x = (v < 4) ? pc_[v * D + c] : pcc_[c]; sl[i] = silu_f(x); }
                __syncthreads(); staged = true;
            }
            const float* W = pwm_ + (size_t)layer * D * 6 * D + jb * 64 + F.lane;
            float a0 = 0.f, a1 = 0.f, a2 = 0.f, a3 = 0.f, a4 = 0.f;
            const int cb = F.wave * 128;
#pragma unroll 8
            for (int c = 0; c < 128; ++c) { const float w = W[(size_t)(cb + c) * 6 * D]; a0 += sl[cb + c] * w; a1 += sl[1024 + cb + c] * w; a2 += sl[2048 + cb + c] * w; a3 += sl[3072 + cb + c] * w; a4 += sl[4096 + cb + c] * w; }
            red[(F.wave * 5 + 0) * 64 + F.lane] = a0; red[(F.wave * 5 + 1) * 64 + F.lane] = a1; red[(F.wave * 5 + 2) * 64 + F.lane] = a2; red[(F.wave * 5 + 3) * 64 + F.lane] = a3; red[(F.wave * 5 + 4) * 64 + F.lane] = a4;
            __syncthreads();
            if (F.tid < 320) { const int v = F.tid >> 6, l = F.tid & 63; float s = 0.f;
#pragma unroll
                for (int w = 0; w < 8; ++w) s += red[(w * 5 + v) * 64 + l];
                const int j = jb * 64 + l;
                ((float*)(F.ws + WS_MOD))[(size_t)(layer * 5 + v) * 6 * D + j] = s + pbm_[layer * 6 * D + j]; }
            __syncthreads();
        }
        __syncthreads();
    }
    for (int i = F.bid * NTHREADS + F.tid; i < SEQ * 16; i += F.G * NTHREADS) {
        const int t = i >> 4, p = i & 15; const float pos = (p < 8) ? (float)(t >> 6) : (float)(t & 63);
        const float inv = powf(10000.0f, -(float)(p & 7) / 8.0f); const float ang = pos * inv; float s, c; sincosf(ang, &s, &c);
        float* T = (float*)(F.ws + WS_ROPEM) + (size_t)t * 32; T[p] = c; T[16 + p] = s;
    }
    for (int i = F.bid * NTHREADS + F.tid; i < SEQ * 32; i += F.G * NTHREADS) {
        const int t = i >> 5, p = i & 31; const float pos = (p < 16) ? (float)(t >> 6) : (float)(t & 63);
        const float inv = powf(10000.0f, -(float)(p & 15) / 16.0f); const float ang = pos * inv; float s, c; sincosf(ang, &s, &c);
        float* T = (float*)(F.ws + WS_ROPEG) + (size_t)t * 64; T[p] = c; T[32 + p] = s;
    }
    zero_rect(F, (bf16_t*)(F.ws + WS_WAIN), 1024, ATTN_IN, ATTN_INP - ATTN_IN, 0, 1024);
    zero_rect(F, (bf16_t*)(F.ws + WS_WUP), UPK, 0, 768, 256, 128);
    zero_rect(F, (bf16_t*)(F.ws + WS_WUP), UPK, 768, 1024, 0, 256);
    zero_rect(F, (bf16_t*)(F.ws + WS_WSIN), 1024, 4608 + 16, SSM_INP - 4608 - 16, 0, 1024);
    LAS float* scr = (LAS float*)(F.lds + F.wave * 16896);
    const int gw = F.bid * NWAVES + F.wave, NGW = F.G * NWAVES;
#define SEG(Wp, ldn, Kk, c0, nc, WTp, ldk, r0, kk0, nbatch, sstride, dstride) { const int nnb = ((nc) + 31) / 32, per = ((Kk) / 64) * nnb; const int ni = (nbatch) * per; \
        if (r < ni) { const int bb = r / per, q = r % per, kb = q / nnb, nb = q % nnb; const int nv = ((nc) - nb * 32) < 32 ? ((nc) - nb * 32) : 32; \
            tr_item((Wp) + (size_t)bb * (sstride), (ldn), kb * 64, (c0) + nb * 32, nv, (WTp) + (size_t)bb * (dstride), (ldk), (r0) + nb * 32, (kk0), scr, F.lane); continue; } r -= ni; }
#define SEG8(Wp, ldn, Kk, nc, WTp, ldk, nbatch, sstride, dstride) { const int nnb = (nc) / 32, per = ((Kk) / 128) * nnb; const int ni = (nbatch) * per; \
        if (r < ni) { const int bb = r / per, q = r % per, kb = q / nnb, nb = q % nnb; \
            tr_item8((Wp) + (size_t)bb * (sstride), (ldn), kb * 128, nb * 32, (WTp) + (size_t)bb * (dstride), (ldk), nb * 32, FP8_SW, scr, F.lane); continue; } r -= ni; }
    constexpr int N_ITEMS_TOTAL = 16 * 37 + 4 * 24 + 2 * 32 + 16 * 32 + 16 * (32 + 48 + 32 + 32 + 1) + 32 * 32;
    for (int it = gw; it < N_ITEMS_TOTAL; it += NGW) {
        int r = it;
        SEG(inp(I_AWIN), ATTN_IN, 1024, 0, ATTN_IN, (bf16_t*)(F.ws + WS_WAIN), 1024, 0, 0, 1, 0, 0)
        SEG(inp(I_WUQ), 768, 256, 0, 768, (bf16_t*)(F.ws + WS_WUP), UPK, 0, 0, 1, 0, 0)
        SEG(inp(I_WUKV), 1024, 128, 0, 1024, (bf16_t*)(F.ws + WS_WUP), UPK, 768, 256, 1, 0, 0)
        SEG(inp(I_AWOUT), 1024, 1024, 0, 1024, (bf16_t*)(F.ws + WS_WAOUT), 1024, 0, 0, 1, 0, 0)
        SEG(inp(I_SWIN), SSM_IN, 1024, 0, 1024, (bf16_t*)(F.ws + WS_WSIN), 1024, 0, 0, 1, 0, 0)
        SEG(inp(I_SWIN), SSM_IN, 1024, 1024, 1536, (bf16_t*)(F.ws + WS_WSIN), 1024, 1024, 0, 1, 0, 0)
        SEG(inp(I_SWIN), SSM_IN, 1024, 2576, 1024, (bf16_t*)(F.ws + WS_WSIN), 1024, 2560, 0, 1, 0, 0)
        SEG(inp(I_SWIN), SSM_IN, 1024, 3600, 1024, (bf16_t*)(F.ws + WS_WSIN), 1024, 3584, 0, 1, 0, 0)
        SEG(inp(I_SWIN), SSM_IN, 1024, 2560, 16, (bf16_t*)(F.ws + WS_WSIN), 1024, 4608, 0, 1, 0, 0)
        SEG(inp(I_SWOUT), 1024, 2048, 0, 1024, (bf16_t*)(F.ws + WS_WSOUT), 2048, 0, 0, 1, 0, 0)
    }
#undef SEG
#undef SEG8
}

__device__ __forceinline__ void norm_mod_store(const f32x4 (&v)[4], const float* g, const float* sh, const float* sc, bf16_t* orow, int lane) {
    float s = 0.f;
#pragma unroll
    for (int j = 0; j < 4; ++j) s += (v[j].x * v[j].x + v[j].y * v[j].y) + (v[j].z * v[j].z + v[j].w * v[j].w);
    f32x4 gg[4], ss[4], cc[4];
#pragma unroll
    for (int j = 0; j < 4; ++j) { const int c = 4 * lane + 256 * j; gg[j] = *(const f32x4*)(g + c); ss[j] = *(const f32x4*)(sh + c); cc[j] = *(const f32x4*)(sc + c); }
    __builtin_amdgcn_sched_barrier(0);
    const float inv = rsqrtf(wave_sum(s) * (1.0f / D) + EPS);
#pragma unroll
    for (int j = 0; j < 4; ++j) { const int c = 4 * lane + 256 * j;
        const float y0 = v[j].x * inv * gg[j].x * (1.f + cc[j].x) + ss[j].x, y1 = v[j].y * inv * gg[j].y * (1.f + cc[j].y) + ss[j].y, y2 = v[j].z * inv * gg[j].z * (1.f + cc[j].z) + ss[j].z, y3 = v[j].w * inv * gg[j].w * (1.f + cc[j].w) + ss[j].w;
        *(u32x2*)(orow + c) = (u32x2){cvtpk(y0, y1), cvtpk(y2, y3)}; }
}
__device__ __forceinline__ void p1_norm_mod(const Frame& F) {
    const int gw = F.bid * NWAVES + F.wave, NGW = F.G * NWAVES; const float* ng_ = inp(I_NORMG);
    for (int r = gw; r < MR; r += NGW) {
        const float* xr = src_row(F, r); f32x4 v[4];
#pragma unroll
        for (int j = 0; j < 4; ++j) v[j] = *(const f32x4*)(xr + 4 * F.lane + 256 * j);
        norm_mod_store(v, ng_, mod_vec(F, 0, r, 0), mod_vec(F, 0, r, 1), (bf16_t*)(F.ws + WS_H) + (size_t)r * D, F.lane);
    }
}
using pg8::GUnit;
__device__ __forceinline__ bool tile_of(int L, int nM, int nN, int& pm, int& pn) {
    const int nwg = nM * nN; if (L >= nwg) return false;
    int wgid = L; { const int q = nwg / 8, r = nwg % 8, xcd = wgid % 8, off = wgid / 8; wgid = (xcd < r ? xcd * (q + 1) : r * (q + 1) + (xcd - r) * q) + off; }
    const int nig = 8 * nN, gid = wgid / nig, fm = gid * 8, gsz = (nM - fm) < 8 ? (nM - fm) : 8;
    pm = fm + ((wgid % nig) % gsz); pn = (wgid % nig) / gsz; return true;
}
struct DenseOrder {
    const char* A; const char* B; int KB, nM, nN, G, c; bool lat_only;
    int pair0, pbase0, pbase1;
    int npair;
    unsigned ctx_mask;
    int nme = 0;
    __device__ __forceinline__ bool next(int i, GUnit& u) const {
        int pm, pn; const int L = i * G + c; int rt;
        if (ctx_mask != 0u && L >= 64 * nN) {
            const int nc = __builtin_popcount(ctx_mask); const int q = L - 64 * nN; if (q >= 4 * nc) return false;
            const int b = q / nc; int k = q % nc; unsigned m = ctx_mask; for (int j = 0; j < k; ++j) m &= m - 1u; pn = __builtin_ctz(m); rt = b * 17;
        } else {
            if (nme > 0) { const int ne = nme * nN; if (L < ne) (void)tile_of(L, nme, nN, pm, pn); else { if (!tile_of(L - ne, nM - nme, nN, pm, pn)) return false; pm += nme; } }
            else if (!tile_of(L, nM, nN, pm, pn)) return false;
            rt = lat_only ? (pm >> 4) * 17 + 1 + (pm & 15) : pm; }
        u.row0 = rt * 256; u.A = A + (size_t)u.row0 * KB; u.rows = nullptr; u.nrows = 0; u.e = pn;
        if (pn >= pair0 && pn < pair0 + npair) { const int j = pn - pair0; u.col0 = pbase0 + 128 * j; u.col1 = pbase1 + 128 * j; }
        else { u.col0 = 256 * pn; u.col1 = u.col0 + 128; }
        u.B0 = B + (size_t)u.col0 * KB; u.B1 = B + (size_t)u.col1 * KB; return true;
    }
};
#define EPI_LOOP_BEGIN \
    _Pragma("unroll") for (int ai = 0; ai < 2; ++ai) _Pragma("unroll") for (int m = 0; m < 4; ++m) { const int row = u.row0 + 128 * ai + 64 * wr + 16 * m + fr; \
    _Pragma("unroll") for (int bj = 0; bj < 2; ++bj) { const int col = (bj ? u.col1 : u.col0) + 32 * wc + 8 * fq; const f32x4 v0 = acc[ai][bj][m][0], v1 = acc[ai][bj][m][1];
#define EPI_LOOP_END } __builtin_amdgcn_sched_barrier(0); }

__device__ __forceinline__ u32x4 pack8(const f32x4& a, const f32x4& b) { return (u32x4){cvtpk(a.x, a.y), cvtpk(a.z, a.w), cvtpk(b.x, b.y), cvtpk(b.z, b.w)}; }
#define EPI_NO_PUB static constexpr bool PUB = false; __device__ __forceinline__ unsigned* ready_flag(const GUnit&) const { return nullptr; }
#define EPI_ZERO_INIT __device__ __forceinline__ void init(f32x4 (&bi)[2][2], const GUnit&, int, int) const { bi[0][0] = bi[0][1] = bi[1][0] = bi[1][1] = (f32x4){0.f, 0.f, 0.f, 0.f}; }
struct EpiBf16 {
    bf16_t* C; int ldc; unsigned* rdy; EPI_ZERO_INIT
    static constexpr bool PUB = true; __device__ __forceinline__ unsigned* ready_flag(const GUnit& u) const { return rdy + 64 * (u.row0 >> 8); }
    __device__ __forceinline__ void operator()(const f32x4 (&acc)[2][2][4][2], const GUnit& u, int wr, int wc, int fr, int fq) const {
        EPI_LOOP_BEGIN
            store_wt16(C + (size_t)row * ldc + col, pack8(v0, v1));
        EPI_LOOP_END
    }
};

struct EpiUp {
    bf16_t* Qm; bf16_t* Km; bf16_t* Vm; EPI_ZERO_INIT EPI_NO_PUB
    __device__ __forceinline__ void operator()(const f32x4 (&acc)[2][2][4][2], const GUnit& u, int wr, int wc, int fr, int fq) const {
        EPI_LOOP_BEGIN
            if (col < 768) { *(u32x4*)(Qm + (size_t)row * 768 + col) = pack8(v0 * C2M, v1 * C2M); }
            else { const int c2 = col - 768, hd = c2 >> 7, w = c2 & 127;
                if (w < 64) *(u32x4*)(Km + (size_t)row * 768 + hd * 96 + w) = pack8(v0, v1);
                else *(u32x4*)(Vm + (size_t)row * 512 + hd * 64 + (w - 64)) = pack8(v0, v1); }
        EPI_LOOP_END
    }
};
template <bool LAYER0> struct EpiResid {
    Frame F; const bf16_t* R; bf16_t* O; int layer; unsigned* rdy; EPI_ZERO_INIT
    static constexpr bool PUB = LAYER0; __device__ __forceinline__ unsigned* ready_flag(const GUnit& u) const { return rdy + 64 * (u.row0 >> 8); }
    __device__ __forceinline__ void operator()(const f32x4 (&acc)[2][2][4][2], const GUnit& u, int wr, int wc, int fr, int fq) const {
        f32x4 g[2][2];
#pragma unroll
        for (int bj = 0; bj < 2; ++bj) { const float* gp = mod_vec(F, layer, u.row0, 2) + (bj ? u.col1 : u.col0) + 32 * wc + 8 * fq; g[bj][0] = *(const f32x4*)gp; g[bj][1] = *(const f32x4*)(gp + 4); }
#pragma unroll
        for (int ai = 0; ai < 2; ++ai) {
            f32x4 r[4][2][2];
#pragma unroll
            for (int m = 0; m < 4; ++m) { const int row = u.row0 + 128 * ai + 64 * wr + 16 * m + fr;
#pragma unroll
                for (int bj = 0; bj < 2; ++bj) { const int col = (bj ? u.col1 : u.col0) + 32 * wc + 8 * fq;
                    if (LAYER0) { const float* rp = src_row(F, row) + col; r[m][bj][0] = *(const f32x4*)rp; r[m][bj][1] = *(const f32x4*)(rp + 4); }
                    else { const u32x4 rv = *(const u32x4*)(R + (size_t)row * D + col); r[m][bj][0] = (f32x4){bflo(rv.x), bfhi(rv.x), bflo(rv.y), bfhi(rv.y)}; r[m][bj][1] = (f32x4){bflo(rv.z), bfhi(rv.z), bflo(rv.w), bfhi(rv.w)}; } } }
            __builtin_amdgcn_sched_barrier(0);
#pragma unroll
            for (int m = 0; m < 4; ++m) { const int row = u.row0 + 128 * ai + 64 * wr + 16 * m + fr;
#pragma unroll
                for (int bj = 0; bj < 2; ++bj) { const int col = (bj ? u.col1 : u.col0) + 32 * wc + 8 * fq;
                    const u32x4 ov = pack8(r[m][bj][0] + g[bj][0] * acc[ai][bj][m][0], r[m][bj][1] + g[bj][1] * acc[ai][bj][m][1]);
                    if (LAYER0) store_wt16(O + (size_t)row * D + col, ov);
                    else *(u32x4*)(O + (size_t)row * D + col) = ov; } }
            __builtin_amdgcn_sched_barrier(0);
        }
    }
};
struct EpiSsmIn {
    bf16_t* Z; bf16_t* XR; bf16_t* V; float* DTR; EPI_ZERO_INIT EPI_NO_PUB
    __device__ __forceinline__ void operator()(const f32x4 (&acc)[2][2][4][2], const GUnit& u, int wr, int wc, int fr, int fq) const {
        const int pn = u.e;
        if (pn >= 10 && pn < 18) {
#pragma unroll
            for (int ai = 0; ai < 2; ++ai)
#pragma unroll
                for (int m = 0; m < 4; ++m) { const int row = u.row0 + 128 * ai + 64 * wr + 16 * m + fr; const int col = (u.col0 - 2560) + 32 * wc + 8 * fq;
                    f32x4 a0 = acc[ai][0][m][0], a1 = acc[ai][0][m][1]; const f32x4 b0 = acc[ai][1][m][0], b1 = acc[ai][1][m][1];
#pragma unroll
                    for (int j = 0; j < 4; ++j) { a0[j] *= sigmoid_f(b0[j]); a1[j] *= sigmoid_f(b1[j]); }
                    *(u32x4*)(V + (size_t)row * D + col) = pack8(a0, a1); }
        } else {
            EPI_LOOP_BEGIN
                if (col < 1024) *(u32x4*)(Z + (size_t)row * D + col) = pack8(v0, v1);
                else if (col < 2560) *(u32x4*)(XR + (size_t)row * XBC + (col - 1024)) = pack8(v0, v1);
                else if (col >= 4608 && col < 4624) { float* p = DTR + (size_t)row * 16 + (col - 4608); *(f32x4*)p = v0; *(f32x4*)(p + 4) = v1; }
            EPI_LOOP_END
        }
    }
};

__device__ __forceinline__ const LAS int* lds_vptr(const LAS int* p) { const LAS int* v; asm volatile("v_mov_b32 %0, %1" : "=v"(v) : "s"(p)); return v; }
struct MoeOrder {
    const LAS int* tab; const char* A; const char* B; int KB, nN, G, c; bool slots; size_t b_expert_bytes; int pair;
    __device__ __forceinline__ bool next(int i, GUnit& u) const {
        const LAS int* tab = lds_vptr(this->tab);
        const int nrb = __builtin_amdgcn_readfirstlane(tab[32]); const int nunits = nrb * nN; int L = i * G + c; if (L >= nunits) return false;
        { const int q = nunits / 8, r = nunits % 8, xcd = L % 8, off = L / 8; L = (xcd < r ? xcd * (q + 1) : r * (q + 1) + (xcd - r) * q) + off; }
        const int rb = L / nN, pn = L % nN;
        int e;
        { const int ln = pg8::pg8_lane(); const int tv = tab[ln & 31];
          e = __builtin_popcountll(__ballot(ln >= 1 && ln < 32 && tv <= rb)); }
        e = __builtin_amdgcn_readfirstlane(e);
        const int j = __builtin_amdgcn_readfirstlane(rb - tab[e]); const int cnt = __builtin_amdgcn_readfirstlane(tab[66 + e]);
        u.e = e; u.row0 = __builtin_amdgcn_readfirstlane(tab[33 + e]) + 256 * j;
        u.rows = nullptr; u.nrows = cnt - 256 * j; u.A = A + (slots ? ((size_t)e * MR + 256 * j) : (size_t)u.row0) * KB;
        const char* Be = B + (size_t)e * b_expert_bytes;
        if (pair) { u.col0 = 128 * pn; u.col1 = 1024 + 128 * pn; } else { u.col0 = 256 * pn; u.col1 = 256 * pn + 128; }
        u.B0 = Be + (size_t)u.col0 * KB; u.B1 = Be + (size_t)u.col1 * KB; return true;
    }
};
__device__ __forceinline__ void moe_table(const Frame& F, const unsigned* cnt, LAS int* tab) {
    if (F.tid < 64) {
        const int e = F.lane & 31; const int c = (int)__hip_atomic_load(cnt + 64 * e, __ATOMIC_RELAXED, __HIP_MEMORY_SCOPE_AGENT); const int nb = (c + 255) >> 8;
        int incl = nb;
#pragma unroll
        for (int o = 1; o < 32; o <<= 1) { const int t = __shfl_up(incl, o, 32); if (e >= o) incl += t; }
        if (F.lane < 32) { tab[e] = incl - nb; tab[33 + e] = (incl - nb) * 256; tab[66 + e] = c; if (e == 31) { tab[32] = incl; tab[65] = incl * 256; } }
    }
    __syncthreads();
}
struct EpiSwiglu {
    EPI_NO_PUB
    unsigned char* ACT; const float* bgu;
    __device__ __forceinline__ void init(f32x4 (&bi)[2][2], const GUnit& u, int wc, int fq) const {
        const float* bp = bgu + (size_t)u.e * 2048 + u.col0 + 32 * wc + 8 * fq;
        const float k = FP8_SW * FP8_SH;
        bi[0][0] = *(const f32x4*)bp * k; bi[0][1] = *(const f32x4*)(bp + 4) * k; bi[1][0] = *(const f32x4*)(bp + 1024) * k; bi[1][1] = *(const f32x4*)(bp + 1028) * k; }
    __device__ __forceinline__ void operator()(const f32x4 (&acc)[2][2][4][2], const GUnit& u, int wr, int wc, int fr, int fq) const {
        const int col = u.col0 + 32 * wc + 8 * fq;
#pragma unroll
        for (int ai = 0; ai < 2; ++ai)
#pragma unroll
            for (int m = 0; m < 4; ++m) { const int row = u.row0 + 128 * ai + 64 * wr + 16 * m + fr;
                constexpr float K1 = FP8_SW * FP8_SH, LIM = 7.0f * K1, KE = -1.702f * LOG2E / K1, KO = FP8_SA / (K1 * K1);
                f32x4 g0 = acc[ai][0][m][0], g1 = acc[ai][0][m][1]; const f32x4 p0 = acc[ai][1][m][0], p1 = acc[ai][1][m][1];
#pragma unroll
                for (int j = 0; j < 4; j += 2) {
                    const f32x2 ga = (f32x2){__builtin_amdgcn_fmed3f(g0[j], -3.0e38f, LIM), __builtin_amdgcn_fmed3f(g0[j + 1], -3.0e38f, LIM)}, gb = (f32x2){__builtin_amdgcn_fmed3f(g1[j], -3.0e38f, LIM), __builtin_amdgcn_fmed3f(g1[j + 1], -3.0e38f, LIM)};
                    const f32x2 ua = (f32x2){__builtin_amdgcn_fmed3f(p0[j], -LIM, LIM), __builtin_amdgcn_fmed3f(p0[j + 1], -LIM, LIM)}, ub = (f32x2){__builtin_amdgcn_fmed3f(p1[j], -LIM, LIM), __builtin_amdgcn_fmed3f(p1[j + 1], -LIM, LIM)};
                    const f32x2 ta = ga * KE, tb = gb * KE;
                    const f32x2 da = (f32x2){__builtin_amdgcn_exp2f(ta.x), __builtin_amdgcn_exp2f(ta.y)} + 1.0f, db = (f32x2){__builtin_amdgcn_exp2f(tb.x), __builtin_amdgcn_exp2f(tb.y)} + 1.0f;
                    const f32x2 sa = (f32x2){__builtin_amdgcn_rcpf(da.x), __builtin_amdgcn_rcpf(da.y)}, sb = (f32x2){__builtin_amdgcn_rcpf(db.x), __builtin_amdgcn_rcpf(db.y)};
                    const f32x2 ra = ((ua * KO + K1 * KO) * ga) * sa, rb = ((ub * KO + K1 * KO) * gb) * sb;
                    g0[j] = ra.x; g0[j + 1] = ra.y; g1[j] = rb.x; g1[j + 1] = rb.y; }
                *(u32x2*)(ACT + (size_t)row * D + col) = (u32x2){pk4_fp8_nc(g0[0], g0[1], g0[2], g0[3]), pk4_fp8_nc(g1[0], g1[1], g1[2], g1[3])};
                __builtin_amdgcn_sched_barrier(0); }
    }
};
struct EpiYs {
    EPI_NO_PUB
    unsigned char* YS; const float* bdn;
    __device__ __forceinline__ void init(f32x4 (&bi)[2][2], const GUnit& u, int wc, int fq) const {
        const float* bp = bdn + (size_t)u.e * D + 32 * wc + 8 * fq;
        const float k = FP8_SW * FP8_SA;
        bi[0][0] = *(const f32x4*)(bp + u.col0) * k; bi[0][1] = *(const f32x4*)(bp + u.col0 + 4) * k; bi[1][0] = *(const f32x4*)(bp + u.col1) * k; bi[1][1] = *(const f32x4*)(bp + u.col1 + 4) * k; }
    __device__ __forceinline__ void operator()(const f32x4 (&acc)[2][2][4][2], const GUnit& u, int wr, int wc, int fr, int fq) const {
        EPI_LOOP_BEGIN
            constexpr float ik = FP8_SY / (FP8_SW * FP8_SA);
            *(u32x2*)(YS + (size_t)row * D + col) = (u32x2){pk4_fp8(v0.x * ik, v0.y * ik, v0.z * ik, v0.w * ik), pk4_fp8(v1.x * ik, v1.y * ik, v1.z * ik, v1.w * ik)};
        EPI_LOOP_END
    }
};
__device__ __forceinline__ void p3_attn_post(const Frame& F, unsigned* rdy) {
    const int gw = F.bid * NWAVES + F.wave, NGW = F.G * NWAVES, lane = F.lane;
    const bf16_t* U0 = (const bf16_t*)(F.ws + WS_U0);
    bf16_t* CQ = (bf16_t*)(F.ws + WS_CQKV); bf16_t* Km = (bf16_t*)(F.ws + WS_KM); bf16_t* Qg = (bf16_t*)(F.ws + WS_QG); bf16_t* Kg = (bf16_t*)(F.ws + WS_KG); bf16_t* Vg = (bf16_t*)(F.ws + WS_VG);
    const float* ropeM = (const float*)(F.ws + WS_ROPEM); const float* ropeG = (const float*)(F.ws + WS_ROPEG);
    const float* gcq = inp(I_GCQ); const float* gckv = inp(I_GCKV); const float* gq = inp(I_GQ); const float* gk = inp(I_GK);
    const int per = (MR + NGW - 1) / NGW;
    int a0 = gw * per, na = min(per, max(MR - a0, 0)), b0 = 0, nb = 0;
    int ea0 = F.bid * NWAVES * per, ea1 = min(ea0 + NWAVES * per, MR), lb0 = 0, lb1 = 0;
    if (F.G == 256) {
        const int x3 = min(max(F.bid - 168, 0), 32); nb = (F.bid >= 168 && F.bid < 200) ? 3 : 2;
        lb0 = 13056 + 16 * F.bid + 8 * x3; lb1 = lb0 + 8 * nb; b0 = lb0 + F.wave * nb;
        if (F.bid < 84) { na = 0; ea0 = ea1 = 0; }
        else { const int lw = gw - 672, lw0 = (F.bid - 84) * 8; a0 = lw * 9 + min(lw, 672); na = 9 + (lw < 672 ? 1 : 0); ea0 = lw0 * 9 + min(lw0, 672); ea1 = (lw0 + 8) * 9 + min(lw0 + 8, 672); }
    }
    const int l16 = lane & 15, part = lane & 7;
    const f32x4 g_cq = *(const f32x4*)(gcq + 4 * lane); const f32x2 g_ckv = *(const f32x2*)(gckv + 2 * lane);
    const f32x4 g_q0 = *(const f32x4*)(gq + part * 8), g_q1 = *(const f32x4*)(gq + part * 8 + 4), g_k0 = *(const f32x4*)(gk + part * 8), g_k1 = *(const f32x4*)(gk + part * 8 + 4);
    struct P3Row { u32x2 cq; unsigned ckv, kr; u32x4 qg, kg, vg; float mc, ms; f32x4 gc, gs; };
    auto load_row = [&](int r, P3Row& R) {
        const bf16_t* ur = U0 + (size_t)r * ATTN_INP; const int tp = r % TPB; const int t = tp >= CTXL ? tp - CTXL : 0;
        R.cq = *(const u32x2*)(ur + 4 * lane); R.ckv = *(const unsigned*)(ur + 256 + 2 * lane); R.kr = *(const unsigned*)(ur + 384 + 2 * l16);
        R.qg = *(const u32x4*)(ur + 416 + 8 * lane); R.kg = *(const u32x4*)(ur + 928 + l16 * 8); R.vg = *(const u32x4*)(ur + 1056 + l16 * 8);
        R.mc = ropeM[(size_t)t * 32 + l16]; R.ms = ropeM[(size_t)t * 32 + 16 + l16];
        const float* T = ropeG + (size_t)t * 64 + part * 4; R.gc = *(const f32x4*)T; R.gs = *(const f32x4*)(T + 32);
    };
    auto finish_row = [&](int r, const P3Row& R) {
        const bool lat = (r % TPB) >= CTXL;
        { const f32x4 v = (f32x4){bflo(R.cq.x), bfhi(R.cq.x), bflo(R.cq.y), bfhi(R.cq.y)}; const float s = wave_sum((v.x * v.x + v.y * v.y) + (v.z * v.z + v.w * v.w)); const float inv = rsqrtf(s * (1.f / 256.f) + EPS);
          *(u32x2*)(CQ + (size_t)r * UPK + 4 * lane) = (u32x2){cvtpk(v.x * inv * g_cq.x, v.y * inv * g_cq.y), cvtpk(v.z * inv * g_cq.z, v.w * inv * g_cq.w)}; }
        { const f32x2 v = (f32x2){bflo(R.ckv), bfhi(R.ckv)}; const float s = wave_sum(v.x * v.x + v.y * v.y); const float inv = rsqrtf(s * (1.f / 128.f) + EPS);
          *(unsigned*)(CQ + (size_t)r * UPK + 256 + 2 * lane) = cvtpk(v.x * inv * g_ckv.x, v.y * inv * g_ckv.y); }
        { const f32x2 v = (f32x2){bflo(R.kr), bfhi(R.kr)}; float e = v.x, o = v.y;
            if (lat) { e = v.x * R.mc - v.y * R.ms; o = v.x * R.ms + v.y * R.mc; }
            const unsigned w = cvtpk(e, o);
            if (lane < 16) {
#pragma unroll
                for (int hd = 0; hd < 8; ++hd) *(unsigned*)(Km + (size_t)r * 768 + hd * 96 + 64 + 2 * lane) = w; } }
        { const u32x4 w = R.qg; f32x4 a = (f32x4){bflo(w.x), bfhi(w.x), bflo(w.y), bfhi(w.y)}, b = (f32x4){bflo(w.z), bfhi(w.z), bflo(w.w), bfhi(w.w)};
          float s = (a.x * a.x + a.y * a.y) + (a.z * a.z + a.w * a.w) + (b.x * b.x + b.y * b.y) + (b.z * b.z + b.w * b.w);
          s += __shfl_xor(s, 1); s += __shfl_xor(s, 2); s += __shfl_xor(s, 4); const float inv = rsqrtf(s * (1.f / 64.f) + EPS);
          a = a * inv * g_q0; b = b * inv * g_q1;
          if (lat) { const f32x4 cs = R.gc, sn = R.gs;
              const f32x4 a2 = (f32x4){a.x * cs.x - a.y * sn.x, a.x * sn.x + a.y * cs.x, a.z * cs.y - a.w * sn.y, a.z * sn.y + a.w * cs.y};
              const f32x4 b2 = (f32x4){b.x * cs.z - b.y * sn.z, b.x * sn.z + b.y * cs.z, b.z * cs.w - b.w * sn.w, b.z * sn.w + b.w * cs.w}; a = a2; b = b2; }
          *(u32x4*)(Qg + (size_t)r * 512 + 8 * lane) = pack8(a * C2G, b * C2G); }
        { const u32x4 w = R.kg; f32x4 a = (f32x4){bflo(w.x), bfhi(w.x), bflo(w.y), bfhi(w.y)}, b = (f32x4){bflo(w.z), bfhi(w.z), bflo(w.w), bfhi(w.w)};
          float s = (a.x * a.x + a.y * a.y) + (a.z * a.z + a.w * a.w) + (b.x * b.x + b.y * b.y) + (b.z * b.z + b.w * b.w);
          s += __shfl_xor(s, 1); s += __shfl_xor(s, 2); s += __shfl_xor(s, 4); const float inv = rsqrtf(s * (1.f / 64.f) + EPS);
          a = a * inv * g_k0; b = b * inv * g_k1;
          if (lat) { const f32x4 cs = R.gc, sn = R.gs;
              const f32x4 a2 = (f32x4){a.x * cs.x - a.y * sn.x, a.x * sn.x + a.y * cs.x, a.z * cs.y - a.w * sn.y, a.z * sn.y + a.w * cs.y};
              const f32x4 b2 = (f32x4){b.x * cs.z - b.y * sn.z, b.x * sn.z + b.y * cs.z, b.z * cs.w - b.w * sn.w, b.z * sn.w + b.w * cs.w}; a = a2; b = b2; }
          if (lane < 16) { *(u32x4*)(Kg + (size_t)r * 128 + l16 * 8) = pack8(a, b); *(u32x4*)(Vg + (size_t)r * 128 + l16 * 8) = R.vg; } }
    };
    if (F.tid == 0) wait_rows_ready(rdy, ea0, ea1, 5u);
    __syncthreads();
#pragma unroll 1
    for (int seg = 0; seg < 2; ++seg) {
        const int n = seg ? nb : na, base = seg ? b0 : a0; if (n == 0) continue;
        if (seg) { __syncthreads(); if (F.tid == 0) wait_rows_ready(rdy, lb0, lb1, 5u); __syncthreads(); }
        P3Row cur, nx; load_row(base, cur);
#pragma unroll 1
        for (int it = 0; it < n; ++it) {
            nx = cur; if (it + 1 < n) load_row(base + it + 1, nx);
            __builtin_amdgcn_sched_barrier(0);
            finish_row(base + it, cur); cur = nx;
        }
    }
}

template <int DK> struct AttnCfg { static constexpr int KSTR = DK * 2 + 16, KBYTES = 64 * KSTR, VOFF = KBYTES, BUF = KBYTES + 8192, NKP = 64 * (DK / 8); };
__device__ __forceinline__ s16x4 tr_read(const LAS char* p) { typedef short v4i16_t __attribute__((ext_vector_type(4))); return __builtin_bit_cast(s16x4, __builtin_amdgcn_ds_read_tr16_b64_v4i16((LAS v4i16_t*)p)); }

template <int DK>
__device__ __forceinline__ void attn_unit(const bf16_t* Q, int qpitch, const bf16_t* Kp, int kpitch, const bf16_t* Vp, int vpitch, bf16_t* O, int opitch, int NT, LAS char* lds, int tid, const float* rope  ) {
    typedef AttnCfg<DK> C; constexpr int ND = DK / 16;
    const int lane = tid & 63, wid = __builtin_amdgcn_readfirstlane(tid >> 6), r32 = lane & 31, hi = lane >> 5;
    const int kr0 = tid / (DK / 8), kc0 = tid % (DK / 8); const int p1 = tid + 512; const bool has1 = p1 < C::NKP; const int kr1 = p1 / (DK / 8), kc1 = p1 % (DK / 8);
    const int vr = tid >> 3, vc = tid & 7;
    const bf16_t* kg0 = Kp + (size_t)kr0 * kpitch + kc0 * 8; const bf16_t* kg1 = Kp + (size_t)kr1 * kpitch + kc1 * 8; const bf16_t* vg = Vp + (size_t)vr * vpitch + vc * 8;
    const int kl0 = kr0 * C::KSTR + kc0 * 16, kl1 = kr1 * C::KSTR + kc1 * 16, vl = C::VOFF + (vc >> 2) * 4096 + vr * 64 + (vc & 3) * 16;
    u32x4 sk0, sk1 = (u32x4){0u, 0u, 0u, 0u}, sv;
#define ATT_GLOAD(t_) do { const size_t ko_ = (size_t)(t_) * 64 * kpitch, vo_ = (size_t)(t_) * 64 * vpitch; sk0 = *(const u32x4*)(kg0 + ko_); if (has1) sk1 = *(const u32x4*)(kg1 + ko_); sv = *(const u32x4*)(vg + vo_); } while (0)
#define ATT_LSTORE(b_) do { LAS char* nb_ = lds + (b_) * C::BUF; *(LAS u32x4*)(nb_ + kl0) = sk0; if (has1) *(LAS u32x4*)(nb_ + kl1) = sk1; *(LAS u32x4*)(nb_ + vl) = sv; } while (0)
    ATT_GLOAD(0);
    bf16x8 qf[ND];
#pragma unroll
    for (int d0 = 0; d0 < ND; ++d0) qf[d0] = *(const bf16x8*)(Q + (size_t)(wid * 32 + r32) * qpitch + d0 * 16 + hi * 8);
    if (DK == 96 && rope != nullptr) {
#pragma unroll
        for (int f = 0; f < 2; ++f) { const float* T = rope + (size_t)(wid * 32 + r32) * 32 + 8 * f + 4 * hi; const f32x4 cs = *(const f32x4*)T, sn = *(const f32x4*)(T + 16);
            const u32x4 w = __builtin_bit_cast(u32x4, qf[ND - 2 + f]);
            const float e0 = bflo(w.x), o0 = bfhi(w.x), e1 = bflo(w.y), o1 = bfhi(w.y), e2 = bflo(w.z), o2 = bfhi(w.z), e3 = bflo(w.w), o3 = bfhi(w.w);
            const u32x4 rw = (u32x4){cvtpk(e0 * cs.x - o0 * sn.x, e0 * sn.x + o0 * cs.x), cvtpk(e1 * cs.y - o1 * sn.y, e1 * sn.y + o1 * cs.y), cvtpk(e2 * cs.z - o2 * sn.z, e2 * sn.z + o2 * cs.z), cvtpk(e3 * cs.w - o3 * sn.w, e3 * sn.w + o3 * cs.w)};
            qf[ND - 2 + f] = __builtin_bit_cast(bf16x8, rw); }
    }
    ATT_LSTORE(0);
    if (NT > 1) { ATT_GLOAD(1); ATT_LSTORE(1); }
    __syncthreads();
    const int kfo = r32 * C::KSTR + hi * 16;
    const int vfo = C::VOFF + (4 * hi + ((lane & 15) >> 2)) * 64 + ((lane >> 4) & 1) * 32 + (lane & 3) * 8;
#define ATT_QK(s0_, s1_, buf_) do { \
        _Pragma("unroll") for (int d0 = 0; d0 < ND; ++d0) { \
            const bf16x8 ka_ = *(const LAS bf16x8*)((buf_) + kfo + d0 * 32), kb_ = *(const LAS bf16x8*)((buf_) + kfo + 32 * C::KSTR + d0 * 32); \
            s0_ = __builtin_amdgcn_mfma_f32_32x32x16_bf16(ka_, qf[d0], d0 == 0 ? negm : s0_, 0, 0, 0); \
            s1_ = __builtin_amdgcn_mfma_f32_32x32x16_bf16(kb_, qf[d0], d0 == 0 ? negm : s1_, 0, 0, 0); } } while (0)
    f32x16 o0 = {}, o1 = {}, negm = {};
    float mref = 0.f, lsum = 0.f;
    f32x16 s0, s1, n0, n1;
    ATT_QK(s0, s1, lds);
    int bcur = 0, bnxt = 1, bfree = 2;
#define ATT_STEP(c0_, c1_, x0_, x1_, t_) do { \
        const LAS char* buf = lds + bcur * C::BUF; \
        const bool more2 = ((t_) + 2 < NT); \
        if (more2) ATT_GLOAD((t_) + 2); \
        float mx = fmaxf(c0_[0], c1_[0]); \
        _Pragma("unroll") for (int r = 1; r < 16; ++r) mx = fmaxf(fmaxf(mx, c0_[r]), c1_[r]); \
        mx = fmaxf(mx, __shfl_xor(mx, 32)); \
        if (__any(mx > 6.0f) || (t_) == 0) {                                    \
            const float dl = ((t_) == 0) ? mx : fmaxf(mx, 0.f); const float alpha = __builtin_amdgcn_exp2f(-dl); mref += dl; lsum *= alpha; \
            _Pragma("unroll") for (int r = 0; r < 16; ++r) { o0[r] *= alpha; o1[r] *= alpha; c0_[r] -= dl; c1_[r] -= dl; negm[r] = -mref; } \
        } \
          \
        ATT_QK(x0_, x1_, lds + bnxt * C::BUF); \
        float ps = 0.f; \
        _Pragma("unroll") for (int r = 0; r < 16; ++r) { c0_[r] = __builtin_amdgcn_exp2f(c0_[r]); c1_[r] = __builtin_amdgcn_exp2f(c1_[r]); ps += c0_[r] + c1_[r]; } \
        lsum += ps; \
        _Pragma("unroll") for (int kb = 0; kb < 2; ++kb) _Pragma("unroll") for (int ks = 0; ks < 2; ++ks) { \
                const f32x16& s = kb ? c1_ : c0_; \
                u32x4 pw = (u32x4){cvtpk(s[8 * ks + 0], s[8 * ks + 1]), cvtpk(s[8 * ks + 2], s[8 * ks + 3]), cvtpk(s[8 * ks + 4], s[8 * ks + 5]), cvtpk(s[8 * ks + 6], s[8 * ks + 7])}; \
                const bf16x8 pf = __builtin_bit_cast(bf16x8, pw); \
                const LAS char* vb = buf + vfo + (32 * kb + 16 * ks) * 64; \
                const s16x4 a0 = tr_read(vb), a1 = tr_read(vb + 512), b0 = tr_read(vb + 4096), b1 = tr_read(vb + 4096 + 512); \
                const bf16x8 va = (bf16x8){a0[0], a0[1], a0[2], a0[3], a1[0], a1[1], a1[2], a1[3]}, vb8 = (bf16x8){b0[0], b0[1], b0[2], b0[3], b1[0], b1[1], b1[2], b1[3]}; \
                o0 = __builtin_amdgcn_mfma_f32_32x32x16_bf16(va, pf, o0, 0, 0, 0); \
                o1 = __builtin_amdgcn_mfma_f32_32x32x16_bf16(vb8, pf, o1, 0, 0, 0); } \
        if (more2) ATT_LSTORE(bfree); \
        __syncthreads(); \
        { const int tb = bcur; bcur = bnxt; bnxt = bfree; bfree = tb; } } while (0)
    for (int t = 0; t < NT; t += 2) {
        ATT_STEP(s0, s1, n0, n1, t);
        if (t + 1 < NT) ATT_STEP(n0, n1, s0, s1, t + 1);
    }
#undef ATT_STEP
#undef ATT_GLOAD
#undef ATT_LSTORE
#undef ATT_QK
    lsum += __shfl_xor(lsum, 32);
    const float inv = 1.0f / lsum;
    bf16_t* orow = O + (size_t)(wid * 32 + r32) * opitch;
#pragma unroll
    for (int i = 0; i < 4; ++i) {
        *(u32x2*)(orow + 8 * i + 4 * hi) = (u32x2){cvtpk(o0[4 * i] * inv, o0[4 * i + 1] * inv), cvtpk(o0[4 * i + 2] * inv, o0[4 * i + 3] * inv)};
        *(u32x2*)(orow + 32 + 8 * i + 4 * hi) = (u32x2){cvtpk(o1[4 * i] * inv, o1[4 * i + 1] * inv), cvtpk(o1[4 * i + 2] * inv, o1[4 * i + 3] * inv)};
    }
}

struct BgCvt { const float* wgu; const float* wdn; unsigned char* tgu; unsigned char* tdn; LAS unsigned* scr; int item, end, step; int pitem, pstep; int wv; };
constexpr int BG_GU = 64 * 4 * 8, BG_DN = 64 * 2 * 8, BG_TOTAL = BG_GU + BG_DN;
constexpr int BG_LDS_OFF = 66 * 1024;
__device__ __forceinline__ void bg_addr(const BgCvt& g, int it, const float*& src, int& ldn, unsigned char*& dst) {
    if (it < BG_GU) { const int e = it >> 5, nb = ((it >> 3) & 3) * 8 + g.wv, kq = it & 7; ldn = 2048;
        src = g.wgu + (size_t)e * 1024 * 2048 + (size_t)(kq * 128) * 2048 + nb * 64; dst = g.tgu + (size_t)e * 2048 * 1024 + (size_t)(nb * 64) * 1024 + kq * 128; }
    else { const int s2 = it - BG_GU; const int e = s2 >> 4, nb = ((s2 >> 3) & 1) * 8 + g.wv, kq = s2 & 7; ldn = 1024;
        src = g.wdn + (size_t)e * 1024 * 1024 + (size_t)(kq * 128) * 1024 + nb * 64; dst = g.tdn + (size_t)e * 1024 * 1024 + (size_t)(nb * 64) * 1024 + kq * 128; }
}
#define BG_LOAD(g_, lane_, v_) do { const int it_ = (g_).item < (g_).end ? (g_).item : (g_).end - 1; const int st_ = (g_).step < 16 ? (g_).step : 15; \
        const float* s_; int l_; unsigned char* d_; bg_addr((g_), it_, s_, l_, d_); s_ += (size_t)(st_ * 8) * l_; \
        unsigned lo_ = (unsigned)(lane_) * 4u; asm volatile("" : "+v"(lo_));        \
        _Pragma("unroll") for (int i_ = 0; i_ < 8; ++i_) v_[i_] = *(const float*)((const char*)(s_ + (size_t)i_ * l_) + lo_); } while (0)
#define BG_PACK(g_, lane_, w_) do { if ((g_).pitem >= 0 && (g_).pstep < 16) { \
            (g_).scr[(lane_) * 33 + 2 * (g_).pstep] = pk4_fp8(w_[0] * FP8_SW, w_[1] * FP8_SW, w_[2] * FP8_SW, w_[3] * FP8_SW); \
            (g_).scr[(lane_) * 33 + 2 * (g_).pstep + 1] = pk4_fp8(w_[4] * FP8_SW, w_[5] * FP8_SW, w_[6] * FP8_SW, w_[7] * FP8_SW); } } while (0)
#define BG_FLUSH(g_, lane_) do { \
        if ((g_).pitem >= 0 && (g_).pstep == 16) { const float* s_; int l_; unsigned char* d_; bg_addr((g_), (g_).pitem, s_, l_, d_); LDS_WAIT(); \
            _Pragma("unroll") for (int j_ = 0; j_ < 8; ++j_) { const int n_ = 8 * j_ + ((lane_) >> 3), c_ = (lane_) & 7; const LAS unsigned* p_ = (g_).scr + n_ * 33 + 4 * c_; \
                *(u32x4*)(d_ + (size_t)n_ * 1024 + 16 * c_) = (u32x4){p_[0], p_[1], p_[2], p_[3]}; } \
            LDS_WAIT(); } \
        if ((g_).item < (g_).end) { (g_).pitem = (g_).item; (g_).pstep = (g_).step; if (++(g_).step > 16) { (g_).step = 0; ++(g_).item; } } else (g_).pitem = -1; } while (0)
#ifndef MK_ATT_STAGGER
#define MK_ATT_STAGGER 0
#endif
template <int DK>
__device__ __forceinline__ bool attn_unit_fast(const bf16_t* Q, int qpitch, const bf16_t* Kp, int kpitch, const bf16_t* Vp, int vpitch, bf16_t* O, int opitch, int NT, LAS char* lds, int tid, const float* rope  , BgCvt& bg, float (&bgA)[8], float (&bgB)[8]) {
    typedef AttnCfg<DK> C; constexpr int ND = DK / 16;
    const int lane = tid & 63, wid = __builtin_amdgcn_readfirstlane(tid >> 6), r32 = lane & 31, hi = lane >> 5;
    const int kr0 = tid / (DK / 8), kc0 = tid % (DK / 8); const int p1 = tid + 512; const bool has1 = p1 < C::NKP; const int kr1 = p1 / (DK / 8), kc1 = p1 % (DK / 8);
    const int vr = tid >> 3, vc = tid & 7;
    const int ko0 = kr0 * kpitch + kc0 * 8, ko1 = kr1 * kpitch + kc1 * 8, vo0 = vr * vpitch + vc * 8;
    const int kl0 = kr0 * C::KSTR + kc0 * 16, kl1 = kr1 * C::KSTR + kc1 * 16, vl = C::VOFF + (vc >> 2) * 4096 + vr * 64 + (vc & 3) * 16;
    u32x4 sk0, sk1 = (u32x4){0u, 0u, 0u, 0u}, sv;
#define ATT_GLOAD(t_) do { const bf16_t* kb_ = Kp + (size_t)(t_) * 64 * kpitch; const bf16_t* vb_ = Vp + (size_t)(t_) * 64 * vpitch; int a_ = ko0, b_ = ko1, c_ = vo0; asm volatile("" : "+v"(a_), "+v"(b_), "+v"(c_)); \
        sk0 = *(const u32x4*)(kb_ + a_); if (has1) sk1 = *(const u32x4*)(kb_ + b_); sv = *(const u32x4*)(vb_ + c_); } while (0)
#define ATT_LSTORE(b_) do { LAS char* nb_ = lds + (b_) * C::BUF; *(LAS u32x4*)(nb_ + kl0) = sk0; if (has1) *(LAS u32x4*)(nb_ + kl1) = sk1; *(LAS u32x4*)(nb_ + vl) = sv; } while (0)
    ATT_GLOAD(0);
    bf16x8 qf[ND];
#pragma unroll
    for (int d0 = 0; d0 < ND; ++d0) qf[d0] = *(const bf16x8*)(Q + (size_t)(wid * 32 + r32) * qpitch + d0 * 16 + hi * 8);
    if (DK == 96 && rope != nullptr) {
#pragma unroll
        for (int f = 0; f < 2; ++f) { const float* T = rope + (size_t)(wid * 32 + r32) * 32 + 8 * f + 4 * hi; const f32x4 cs = *(const f32x4*)T, sn = *(const f32x4*)(T + 16);
            const u32x4 w = __builtin_bit_cast(u32x4, qf[ND - 2 + f]);
            const float e0 = bflo(w.x), o0 = bfhi(w.x), e1 = bflo(w.y), o1 = bfhi(w.y), e2 = bflo(w.z), o2 = bfhi(w.z), e3 = bflo(w.w), o3 = bfhi(w.w);
            const u32x4 rw = (u32x4){cvtpk(e0 * cs.x - o0 * sn.x, e0 * sn.x + o0 * cs.x), cvtpk(e1 * cs.y - o1 * sn.y, e1 * sn.y + o1 * cs.y), cvtpk(e2 * cs.z - o2 * sn.z, e2 * sn.z + o2 * cs.z), cvtpk(e3 * cs.w - o3 * sn.w, e3 * sn.w + o3 * cs.w)};
            qf[ND - 2 + f] = __builtin_bit_cast(bf16x8, rw); }
    }
    ATT_LSTORE(0);
    if (NT > 1) { ATT_GLOAD(1); ATT_LSTORE(1); }
    __syncthreads();
    const int kfo = r32 * C::KSTR + hi * 16;
    const int vfo = C::VOFF + (4 * hi + ((lane & 15) >> 2)) * 64 + ((lane >> 4) & 1) * 32 + (lane & 3) * 8;
#define ATT_QK(s0_, s1_, buf_) do { \
        _Pragma("unroll") for (int d0 = 0; d0 < ND; ++d0) { \
            const bf16x8 ka_ = *(const LAS bf16x8*)((buf_) + kfo + d0 * 32), kb_ = *(const LAS bf16x8*)((buf_) + kfo + 32 * C::KSTR + d0 * 32); \
            s0_ = __builtin_amdgcn_mfma_f32_32x32x16_bf16(ka_, qf[d0], d0 == 0 ? zero16 : s0_, 0, 0, 0); \
            s1_ = __builtin_amdgcn_mfma_f32_32x32x16_bf16(kb_, qf[d0], d0 == 0 ? zero16 : s1_, 0, 0, 0); } } while (0)
    f32x16 o0 = {}, o1 = {}, osum = {}; const f32x16 zero16 = {};
    const bf16x8 ones = (bf16x8){0x3F80, 0x3F80, 0x3F80, 0x3F80, 0x3F80, 0x3F80, 0x3F80, 0x3F80};
    f32x16 s0, s1, n0, n1;
    ATT_QK(s0, s1, lds);
    int bcur = 0, bnxt = 1, bfree = 2;
#define ATT_STEP(c0_, c1_, x0_, x1_, t_, bl_, bs_) do { \
        const LAS char* buf = lds + bcur * C::BUF; \
        const bool more2 = ((t_) + 2 < NT); \
        if (more2) ATT_GLOAD((t_) + 2); \
        BG_LOAD(bg, lane, bl_); \
          \
        ATT_QK(x0_, x1_, lds + bnxt * C::BUF); \
        _Pragma("unroll") for (int r = 0; r < 16; ++r) { c0_[r] = __builtin_amdgcn_exp2f(c0_[r]); c1_[r] = __builtin_amdgcn_exp2f(c1_[r]); } \
        _Pragma("unroll") for (int kb = 0; kb < 2; ++kb) _Pragma("unroll") for (int ks = 0; ks < 2; ++ks) { \
                const f32x16& s = kb ? c1_ : c0_; \
                u32x4 pw = (u32x4){cvtpk(s[8 * ks + 0], s[8 * ks + 1]), cvtpk(s[8 * ks + 2], s[8 * ks + 3]), cvtpk(s[8 * ks + 4], s[8 * ks + 5]), cvtpk(s[8 * ks + 6], s[8 * ks + 7])}; \
                const bf16x8 pf = __builtin_bit_cast(bf16x8, pw); \
                const LAS char* vb = buf + vfo + (32 * kb + 16 * ks) * 64; \
                const s16x4 a0 = tr_read(vb), a1 = tr_read(vb + 512), b0 = tr_read(vb + 4096), b1 = tr_read(vb + 4096 + 512); \
                const bf16x8 va = (bf16x8){a0[0], a0[1], a0[2], a0[3], a1[0], a1[1], a1[2], a1[3]}, vb8 = (bf16x8){b0[0], b0[1], b0[2], b0[3], b1[0], b1[1], b1[2], b1[3]}; \
                o0 = __builtin_amdgcn_mfma_f32_32x32x16_bf16(va, pf, o0, 0, 0, 0); \
                o1 = __builtin_amdgcn_mfma_f32_32x32x16_bf16(vb8, pf, o1, 0, 0, 0); \
                osum = __builtin_amdgcn_mfma_f32_32x32x16_bf16(ones, pf, osum, 0, 0, 0); } \
        BG_PACK(bg, lane, bs_); \
        if (more2) ATT_LSTORE(bfree); \
        BG_FLUSH(bg, lane); \
        asm volatile("s_waitcnt lgkmcnt(0)" ::: "memory"); __builtin_amdgcn_s_barrier(); asm volatile("" ::: "memory");        \
        if (MK_ATT_STAGGER > 0 && wid >= 4) __builtin_amdgcn_s_sleep(MK_ATT_STAGGER);        \
        { const int tb = bcur; bcur = bnxt; bnxt = bfree; bfree = tb; } } while (0)
    for (int t = 0; t < NT; t += 2) {
        ATT_STEP(s0, s1, n0, n1, t, bgA, bgB);
        ATT_STEP(n0, n1, s0, s1, t + 1, bgB, bgA);
    }
#undef ATT_STEP
#undef ATT_GLOAD
#undef ATT_LSTORE
#undef ATT_QK
    const float lsum = osum[0];
    const bool bad = !(lsum > 1e-30f && lsum < 1e30f);
    const float inv = __builtin_amdgcn_rcpf(lsum);
    bf16_t* orow = O + (size_t)(wid * 32 + r32) * opitch;
#pragma unroll
    for (int i = 0; i < 4; ++i) {
        *(u32x2*)(orow + 8 * i + 4 * hi) = (u32x2){cvtpk(o0[4 * i] * inv, o0[4 * i + 1] * inv), cvtpk(o0[4 * i + 2] * inv, o0[4 * i + 3] * inv)};
        *(u32x2*)(orow + 32 + 8 * i + 4 * hi) = (u32x2){cvtpk(o1[4 * i] * inv, o1[4 * i + 1] * inv), cvtpk(o1[4 * i + 2] * inv, o1[4 * i + 3] * inv)};
    }
    return __any(bad) != 0;
}

__device__ __forceinline__ void p5_attention(const Frame& F) {
    const bf16_t* Qm = (const bf16_t*)(F.ws + WS_QM); const bf16_t* Km = (const bf16_t*)(F.ws + WS_KM); const bf16_t* Vm = (const bf16_t*)(F.ws + WS_VM);
    const bf16_t* Qg = (const bf16_t*)(F.ws + WS_QG); const bf16_t* Kg = (const bf16_t*)(F.ws + WS_KG); const bf16_t* Vg = (const bf16_t*)(F.ws + WS_VG);
    bf16_t* O = (bf16_t*)(F.ws + WS_O);
    LAS char* lds = (LAS char*)F.lds; volatile LAS unsigned* flag = (volatile LAS unsigned*)(F.lds + 140 * 1024);
    const int vcu = (F.G % 8 == 0) ? (F.bid % 8) * (F.G / 8) + F.bid / 8 : F.bid;
    BgCvt bg; bg.wgu = inp(I_WGU); bg.wdn = inp(I_WDN); bg.tgu = (unsigned char*)(F.ws + WS_WGU); bg.tdn = (unsigned char*)(F.ws + WS_WDN);
    bg.scr = (LAS unsigned*)(F.lds + BG_LDS_OFF + F.wave * 8448); bg.step = 0; bg.pitem = -1; bg.pstep = 0;
    float bgA[8], bgB[8];
#pragma unroll
    for (int i = 0; i < 8; ++i) { bgA[i] = 0.f; bgB[i] = 0.f; }
    { const int per = (BG_TOTAL + F.G - 1) / F.G; bg.wv = F.wave; bg.item = min(F.bid * per, BG_TOTAL); bg.end = min((F.bid + 1) * per, BG_TOTAL); }
    for (int u = vcu; u < 1024 + 64; u += F.G) {
        int type, b, hd, qt, NT;
        if (u < 1024) { type = u >> 9; const int idx = u & 511; b = idx >> 7; hd = (idx >> 4) & 7; qt = 1 + (idx & 15); NT = TPB / 64; }
        else { const int idx = u - 1024; type = idx >> 5; b = (idx >> 3) & 3; hd = idx & 7; qt = 0; NT = CTXL / 64; }
        const size_t qrow = (size_t)b * TPB + 256 * qt, krow = (size_t)b * TPB;
        const float* rope = qt > 0 ? (const float*)(F.ws + WS_ROPEM) + (size_t)(qt - 1) * 256 * 32 : nullptr;
        unsigned redo = 1u;
        int tidu = F.tid; asm volatile("" : "+v"(tidu));
        if (qt > 0) {
            if (F.tid == 0) *flag = 0u;
            bool bad;
            if (type == 0) bad = attn_unit_fast<96>(Qm + qrow * 768 + hd * 96, 768, Km + krow * 768 + hd * 96, 768, Vm + krow * 512 + hd * 64, 512, O + qrow * D + hd * 64, D, NT, lds, tidu, rope, bg, bgA, bgB);
            else bad = attn_unit_fast<64>(Qg + qrow * 512 + hd * 64, 512, Kg + krow * 128 + (hd >> 2) * 64, 128, Vg + krow * 128 + (hd >> 2) * 64, 128, O + qrow * D + 512 + hd * 64, D, NT, lds, tidu, nullptr, bg, bgA, bgB);
            if (bad && F.lane == 0) *flag = 1u;
            __syncthreads();
            redo = *flag;
            __syncthreads();
        }
        if (redo) {
            if (type == 0) attn_unit<96>(Qm + qrow * 768 + hd * 96, 768, Km + krow * 768 + hd * 96, 768, Vm + krow * 512 + hd * 64, 512, O + qrow * D + hd * 64, D, NT, lds, tidu, rope);
            else attn_unit<64>(Qg + qrow * 512 + hd * 64, 512, Kg + krow * 128 + (hd >> 2) * 64, 128, Vg + krow * 128 + (hd >> 2) * 64, 128, O + qrow * D + 512 + hd * 64, D, NT, lds, tidu, nullptr);
        }
    }
    while (bg.item < bg.end || bg.pitem >= 0) { BG_LOAD(bg, F.lane, bgA); BG_PACK(bg, F.lane, bgB); BG_FLUSH(bg, F.lane); BG_LOAD(bg, F.lane, bgB); BG_PACK(bg, F.lane, bgA); BG_FLUSH(bg, F.lane); }
}
constexpr int RSTR = 36;
__device__ __forceinline__ void p7_router(const Frame& F, int layer, const bf16_t* X, bool lat_only, unsigned* rdy, unsigned* cnt) {
    LAS float* wl = (LAS float*)F.lds;
    LAS float* wsc = (LAS float*)(F.lds + 1024 * RSTR * 4) + F.wave * 48;
    LAS unsigned char* rowb = (LAS unsigned char*)(F.lds + 1024 * RSTR * 4 + 8 * 48 * 4) + F.wave * 1024;
    const float* WR = inp(I_WROUTER) + (size_t)layer * D * NE; const float* BR = inp(I_BROUTER) + layer * NE;
    for (int i = F.tid; i < D * NE / 4; i += NTHREADS) { const int c = i >> 3, q = i & 7; *(LAS f32x4*)(wl + c * RSTR + q * 4) = *(const f32x4*)(WR + (size_t)c * NE + q * 4); }
    __syncthreads();
    const int gw = F.bid * NWAVES + F.wave, NGW = F.G * NWAVES, lane = F.lane;
    const float* gn = inp(I_NORMG) + (size_t)(layer * 2 + 1) * D;
    unsigned char* X8 = (unsigned char*)(F.ws + WS_X8); int* TE = (int*)(F.ws + WS_TOPE); int* TP = (int*)(F.ws + WS_TOPP); float* TW = (float*)(F.ws + WS_TOPW);
    const int nrows = lat_only ? NBATCH * SEQ : MR;
    const int per = (nrows + NGW - 1) / NGW;
    float gm[16], shv[16]; int curv = -1;
    bool have_prev = false; int pe = 0, pr = 0; float pw = 0.f; unsigned ppos = 0u; u32x4 prow = (u32x4){0u, 0u, 0u, 0u};
    int a0 = gw * per, na = min(per, max(nrows - a0, 0)), b0 = 0, nb = 0;
    int ea0 = F.bid * NWAVES * per, ea1 = min(ea0 + NWAVES * per, nrows), lb0 = 0, lb1 = 0;
    if (rdy != nullptr && F.G == 256) {
        if (F.bid < 16) { na = 0; nb = 1; b0 = 16384 + 896 + gw; ea0 = ea1 = 0; lb0 = 16384 + 896 + F.bid * 8; lb1 = lb0 + 8; }
        else { const int lw = gw - 128, lw0 = (F.bid - 16) * 8; a0 = lw * 8 + min(lw, 1024); na = 8 + (lw < 1024 ? 1 : 0); nb = lw >= 1024 ? 1 : 0; b0 = 16384 + (lw - 1024);
               ea0 = lw0 * 8 + min(lw0, 1024); ea1 = (lw0 + 8) * 8 + min(lw0 + 8, 1024); if (lw0 >= 1024) { lb0 = 16384 + lw0 - 1024; lb1 = lb0 + 8; } }
    }
    if (rdy != nullptr) { if (F.tid == 0) wait_rows_ready(rdy, ea0, ea1, 4u); __syncthreads(); }
    for (int it = 0; it < na + nb; ++it) {
        const int q = it < na ? a0 + it : b0;
        if (rdy != nullptr && nb != 0 && it == na) { __syncthreads(); if (F.tid == 0) wait_rows_ready(rdy, lb0, lb1, 4u); __syncthreads(); }
        const int r = lat_only ? (q / SEQ) * TPB + CTXL + (q % SEQ) : q;
        { const int b = r / TPB, tp = r - b * TPB; const int v = tp < CTXL ? 4 : b;
          if (v != curv) { curv = v; const float* sh = mod_vec(F, layer, r, 3); const float* sc = mod_vec(F, layer, r, 4);
#pragma unroll
              for (int j = 0; j < 16; ++j) { const int c = lane + 64 * j; gm[j] = gn[c] * (1.f + sc[c]); shv[j] = sh[c]; } } }
        const bf16_t* xr = X + (size_t)r * D;
        float x[16]; float s = 0.f;
#pragma unroll
        for (int j = 0; j < 16; ++j) { x[j] = bf2f(xr[lane + 64 * j]); s += x[j] * x[j]; }
        const float inv = rsqrtf(wave_sum(s) * (1.0f / D) + EPS);
        float lg[32];
#pragma unroll
        for (int e = 0; e < 32; ++e) lg[e] = 0.f;
        f32x4 wa[8], wb[8];
#pragma unroll
        for (int q4 = 0; q4 < 8; ++q4) wa[q4] = *(const LAS f32x4*)(wl + lane * RSTR + q4 * 4);
#pragma unroll
        for (int j = 0; j < 16; ++j) { const int c = lane + 64 * j; const float h = x[j] * inv * gm[j] + shv[j];
            rowb[c] = (unsigned char)(pk4_fp8(h * FP8_SH, 0.f, 0.f, 0.f) & 0xffu);
            if (j < 15) {
#pragma unroll
                for (int q4 = 0; q4 < 8; ++q4) wb[q4] = *(const LAS f32x4*)(wl + (c + 64) * RSTR + q4 * 4); }
            __builtin_amdgcn_sched_group_barrier(0x100, 8, 0);
#pragma unroll
            for (int q4 = 0; q4 < 8; ++q4) { lg[q4 * 4 + 0] += h * wa[q4].x; lg[q4 * 4 + 1] += h * wa[q4].y; lg[q4 * 4 + 2] += h * wa[q4].z; lg[q4 * 4 + 3] += h * wa[q4].w; }
            __builtin_amdgcn_sched_group_barrier(0x2, 40, 0);
#pragma unroll
            for (int q4 = 0; q4 < 8; ++q4) wa[q4] = wb[q4]; }
        float v16[16], v8[8], v4[4], v2[2], v1;
        { const bool up = (lane & 32) != 0;
#pragma unroll
          for (int i = 0; i < 16; ++i) { const float keep = up ? lg[i + 16] : lg[i], give = up ? lg[i] : lg[i + 16]; v16[i] = keep + __shfl_xor(give, 32); } }
        { const bool up = (lane & 16) != 0;
#pragma unroll
          for (int i = 0; i < 8; ++i) { const float keep = up ? v16[i + 8] : v16[i], give = up ? v16[i] : v16[i + 8]; v8[i] = keep + __shfl_xor(give, 16); } }
        { const bool up = (lane & 8) != 0;
#pragma unroll
          for (int i = 0; i < 4; ++i) { const float keep = up ? v8[i + 4] : v8[i], give = up ? v8[i] : v8[i + 4]; v4[i] = keep + __shfl_xor(give, 8); } }
        { const bool up = (lane & 4) != 0;
#pragma unroll
          for (int i = 0; i < 2; ++i) { const float keep = up ? v4[i + 2] : v4[i], give = up ? v4[i] : v4[i + 2]; v2[i] = keep + __shfl_xor(give, 4); } }
        { const bool up = (lane & 2) != 0; const float keep = up ? v2[1] : v2[0], give = up ? v2[0] : v2[1]; v1 = keep + __shfl_xor(give, 2); }
        v1 += __shfl_xor(v1, 1);
        const int e = lane >> 1; const float logit = v1 + BR[e];
        if ((lane & 1) == 0) wsc[e] = logit;
        LDS_WAIT();
        int rank = 0;
#pragma unroll
        for (int k = 0; k < 32; ++k) { const float o = wsc[k]; rank += (o > logit || (o == logit && k < e)) ? 1 : 0; }
        if ((lane & 1) == 0 && rank < 4) { wsc[32 + rank] = __int_as_float(e); wsc[36 + rank] = logit; }
        LDS_WAIT();
        const u32x4 rowv = *(const LAS u32x4*)(rowb + 16 * lane);
        float wk = 0.f; int ek = 0;
        if (lane < 4) { const float l0 = wsc[36], l1 = wsc[37], l2 = wsc[38], l3 = wsc[39]; const float me = wsc[36 + lane]; ek = __float_as_int(wsc[32 + lane]);
            const float den = 1.f + __expf(l1 - l0) + __expf(l2 - l0) + __expf(l3 - l0); wk = __expf(me - l0) * __builtin_amdgcn_rcpf(den); }
        LDS_WAIT();
#define ROUTER_FINISH() do { if (lane < 4) { TE[pr * 4 + lane] = pe; TP[pr * 4 + lane] = (int)ppos; TW[pr * 4 + lane] = pw; wsc[40 + lane] = __int_as_float((int)(pe * MR + ppos)); } \
            LDS_WAIT(); _Pragma("unroll") for (int k = 0; k < 4; ++k) { const int slot = __float_as_int(wsc[40 + k]); *(u32x4*)(X8 + (size_t)slot * D + 16 * lane) = prow; } LDS_WAIT(); } while (0)
        if (have_prev) ROUTER_FINISH();
        if (lane < 4) ppos = atomicAdd(cnt + 64 * ek, 1u);
        pe = ek; pw = wk; pr = r; prow = rowv; have_prev = true;
    }
    if (have_prev) ROUTER_FINISH();
#undef ROUTER_FINISH
    __syncthreads();
}

template <bool FINAL>
__device__ __forceinline__ void p_combine(const Frame& F, int layer, const bf16_t* XI, void* XOv, const unsigned* cnt) {
    LAS int* tab = (LAS int*)F.lds;
    moe_table(F, cnt, tab);
    const float* fing_ = inp(I_FINALG); const float* nng_ = inp(I_NORMG) + (size_t)((layer + 1) * 2) * D;
    const int gw = F.bid * NWAVES + F.wave, NGW = F.G * NWAVES, lane = F.lane;
    const int* TE = (const int*)(F.ws + WS_TOPE); const int* TP = (const int*)(F.ws + WS_TOPP); const float* TW = (const float*)(F.ws + WS_TOPW); const unsigned char* YS = (const unsigned char*)(F.ws + WS_YS);
    const int nrows = FINAL ? NBATCH * SEQ : MR;
    typedef int i32x4 __attribute__((ext_vector_type(4)));
    const int q0 = gw;
    i32x4 ne = {}, np = {}; f32x4 nw = {};
    if (q0 < nrows) { const int r0 = FINAL ? (q0 / SEQ) * TPB + CTXL + (q0 % SEQ) : q0; ne = *(const i32x4*)(TE + r0 * 4); np = *(const i32x4*)(TP + r0 * 4); nw = *(const f32x4*)(TW + r0 * 4); }
    for (int q = gw; q < nrows; q += NGW) {
        const int r = FINAL ? (q / SEQ) * TPB + CTXL + (q % SEQ) : q;
        const float* g2 = mod_vec(F, layer, r, 5);
        const i32x4 ce = ne, cp = np; const f32x4 cw = nw;
        { const int qn = q + NGW; if (qn < nrows) { const int rn = FINAL ? (qn / SEQ) * TPB + CTXL + (qn % SEQ) : qn; ne = *(const i32x4*)(TE + rn * 4); np = *(const i32x4*)(TP + rn * 4); nw = *(const f32x4*)(TW + rn * 4); } }
        unsigned yv[4][4]; u32x2 xv[4]; f32x4 gv[4];
#pragma unroll
        for (int k = 0; k < 4; ++k) { const int row = tab[33 + ce[k]] + cp[k]; const unsigned char* yr = YS + (size_t)row * D;
#pragma unroll
            for (int j = 0; j < 4; ++j) yv[k][j] = *(const unsigned*)(yr + 4 * lane + 256 * j); }
#pragma unroll
        for (int j = 0; j < 4; ++j) { const int c = 4 * lane + 256 * j; xv[j] = *(const u32x2*)(XI + (size_t)r * D + c); gv[j] = *(const f32x4*)(g2 + c); }
        __builtin_amdgcn_sched_barrier(0);
        f32x4 f[4];
#pragma unroll
        for (int j = 0; j < 4; ++j) f[j] = (f32x4){0.f, 0.f, 0.f, 0.f};
#pragma unroll
        for (int k = 0; k < 4; ++k) {
#pragma unroll
            for (int j = 0; j < 4; ++j) { const f32x2 lo = __builtin_amdgcn_cvt_pk_f32_fp8((int)yv[k][j], false), hi = __builtin_amdgcn_cvt_pk_f32_fp8((int)yv[k][j], true); f[j] += (f32x4){lo.x, lo.y, hi.x, hi.y} * (cw[k] * (1.0f / FP8_SY)); } }
        f32x4 v[4];
#pragma unroll
        for (int j = 0; j < 4; ++j) v[j] = (f32x4){bflo(xv[j].x), bfhi(xv[j].x), bflo(xv[j].y), bfhi(xv[j].y)} + gv[j] * f[j];
        if (FINAL) {
            float s = 0.f;
#pragma unroll
            for (int j = 0; j < 4; ++j) s += (v[j].x * v[j].x + v[j].y * v[j].y) + (v[j].z * v[j].z + v[j].w * v[j].w);
            const float inv = rsqrtf(wave_sum(s) * (1.0f / D) + EPS);
            float* orow = (float*)XOv + (size_t)q * D;
#pragma unroll
            for (int j = 0; j < 4; ++j) { const int c = 4 * lane + 256 * j; *(f32x4*)(orow + c) = v[j] * inv * *(const f32x4*)(fing_ + c); }
        } else {
#pragma unroll
            for (int j = 0; j < 4; ++j) *(u32x2*)((bf16_t*)XOv + (size_t)r * D + 4 * lane + 256 * j) = (u32x2){cvtpk(v[j].x, v[j].y), cvtpk(v[j].z, v[j].w)};
            norm_mod_store(v, nng_, mod_vec(F, layer + 1, r, 0), mod_vec(F, layer + 1, r, 1), (bf16_t*)(F.ws + WS_H) + (size_t)r * D, lane);
        }
    }
    __syncthreads();
}
__device__ __forceinline__ void p12_ssd_prep(const Frame& F) {
    const bf16_t* XR = (const bf16_t*)(F.ws + WS_XBCRAW); bf16_t* XB = (bf16_t*)(F.ws + WS_XBC);
    const float* cw = inp(I_SCONVW); const float* cb = inp(I_SCONVB);
    constexpr int RS = 26, NSEG = (MR + RS - 1) / RS;
    for (int task = F.bid * NTHREADS + F.tid; task < NSEG * (XBC / 8); task += F.G * NTHREADS) {
        const int seg = task / (XBC / 8), c8 = (task % (XBC / 8)) * 8; const int r0 = seg * RS;
        u32x4 xin[RS + 4];
#pragma unroll
        for (int i = 0; i < RS + 4; ++i) { int rr = r0 + i - 2; rr = rr < 0 ? 0 : (rr >= MR ? MR - 1 : rr); xin[i] = *(const u32x4*)(XR + (size_t)rr * XBC + c8); }
        f32x4 w[5][2];
#pragma unroll
        for (int k = 0; k < 5; ++k) { w[k][0] = *(const f32x4*)(cw + k * XBC + c8); w[k][1] = *(const f32x4*)(cw + k * XBC + c8 + 4); }
        const f32x4 b0 = *(const f32x4*)(cb + c8), b1 = *(const f32x4*)(cb + c8 + 4);
        __builtin_amdgcn_sched_barrier(0);
#pragma unroll
        for (int i = 0; i < RS; ++i) { const int r = r0 + i; if (r < MR) {
            const int tp = r % TPB; const int lo = tp < CTXL ? 0 : CTXL, hiE = tp < CTXL ? CTXL : TPB;
            f32x4 a0 = b0, a1 = b1;
#pragma unroll
            for (int k = 0; k < 5; ++k) { const int t2 = tp + k - 2; const float m = (t2 >= lo && t2 < hiE) ? 1.f : 0.f; const u32x4 x = xin[i + k];
                a0 += (f32x4){bflo(x.x), bfhi(x.x), bflo(x.y), bfhi(x.y)} * (w[k][0] * m); a1 += (f32x4){bflo(x.z), bfhi(x.z), bflo(x.w), bfhi(x.w)} * (w[k][1] * m); }
            *(u32x4*)(XB + (size_t)r * XBC + c8) = (u32x4){cvtpk(silu_f(a0.x), silu_f(a0.y)), cvtpk(silu_f(a0.z), silu_f(a0.w)), cvtpk(silu_f(a1.x), silu_f(a1.y)), cvtpk(silu_f(a1.z), silu_f(a1.w))}; } }
    }
    const float* DTR = (const float*)(F.ws + WS_DTRAW); float* DT = (float*)(F.ws + WS_DT); const float* dtb_ = inp(I_DTBIAS);
    for (int i = F.bid * NTHREADS + F.tid; i < MR * 32; i += F.G * NTHREADS) {
        const int r = i >> 5, dh = i & 31; const float x = DTR[(size_t)r * 16 + (dh & 15)] + dtb_[dh];
        DT[i] = x > 20.f ? x : log1pf(__expf(x));
    }
}

__device__ __forceinline__ int opaque(int v) { asm volatile("" : "+v"(v)); return v; }
__device__ __forceinline__ bf16x8 frag_row(const LAS char* base, int stride, int row0, int k0, int r32, int hi) { return *(const LAS bf16x8*)(base + (row0 + r32) * stride + (k0 + 8 * hi) * 2); }
template <bool PERM> __device__ __forceinline__ bf16x8 frag_tr(const LAS char* base, int stride, int k0, int col0, int lane) {
    const int hi = lane >> 5, q4 = (lane & 15) >> 2; const int ra = PERM ? (4 * hi + q4) : (8 * hi + q4), rb = PERM ? (8 + 4 * hi + q4) : (8 * hi + 4 + q4);
    const int cb = (col0 + ((lane >> 4) & 1) * 16 + (lane & 3) * 4) * 2;
    const s16x4 a = tr_read(base + (k0 + ra) * stride + cb), b = tr_read(base + (k0 + rb) * stride + cb);
    return (bf16x8){a[0], a[1], a[2], a[3], b[0], b[1], b[2], b[3]};
}
__device__ __forceinline__ int crow(int r, int hi) { return (r & 3) + 8 * (r >> 2) + 4 * hi; }

constexpr int S_BSTR = 272, S_XSTR = 144;
constexpr int S_B = 0, S_C = 128 * S_BSTR, S_X = 2 * 128 * S_BSTR, S_ST = S_X + 128 * S_XSTR;
constexpr int S_ACS = S_ST + 2 * 64 * S_BSTR, S_DTL = S_ACS + 16 * 128 * 4, S_END = S_DTL + 16 * 128 * 4;
static_assert(S_END <= MISC_OFF, "SSD LDS map");

__device__ __forceinline__ void ssd_tables(const Frame& F, int row0, int g) {
    LAS float* acs = (LAS float*)(F.lds + S_ACS); LAS float* dtl = (LAS float*)(F.lds + S_DTL);
    const float* DT = (const float*)(F.ws + WS_DT);
    const int tid = opaque(F.tid); const int combo = tid >> 5, j = tid & 31, dir = combo >> 3, hh = combo & 7, head = g * 8 + hh;
    const float a = -__expf(inp(I_ALOG)[dir * 16 + head]);
    float d[4], c[4]; float run = 0.f;
#pragma unroll
    for (int i = 0; i < 4; ++i) { const int s = 4 * j + i; const int l = dir ? 127 - s : s; d[i] = DT[(size_t)(row0 + l) * 32 + dir * 16 + head]; run += d[i] * a; c[i] = run; }
    float tot = run;
#pragma unroll
    for (int o = 1; o < 32; o <<= 1) { const float t = __shfl_up(tot, o, 32); if (j >= o) tot += t; }
    const float excl = tot - run;
#pragma unroll
    for (int i = 0; i < 4; ++i) { const int s = 4 * j + i; const int l = dir ? 127 - s : s; acs[combo * 128 + l] = c[i] + excl; dtl[combo * 128 + l] = d[i]; }
    __syncthreads();
}
__device__ __forceinline__ void stage_tile(const Frame& F, const bf16_t* g, int gp, LAS char* dst, int stride, int ncol8) {
#pragma unroll 1
    for (int i = opaque(F.tid); i < 128 * ncol8; i += NTHREADS) { const int r = i / ncol8, c = i % ncol8; *(LAS u32x4*)(dst + r * stride + c * 16) = *(const u32x4*)(g + (size_t)r * gp + c * 8); }
}

__device__ __forceinline__ void stage_tile64(const Frame& F, const bf16_t* g, LAS char* dst) {
#pragma unroll 1
    for (int i = opaque(F.tid); i < 64 * 16; i += NTHREADS) { const int r = i >> 4, c = i & 15; *(LAS u32x4*)(dst + r * S_BSTR + c * 16) = *(const u32x4*)(g + (size_t)r * 128 + c * 8); }
}
__device__ __forceinline__ void p13_chunk_states(const Frame& F) {
    const bf16_t* XB = (const bf16_t*)(F.ws + WS_XBC); bf16_t* CH = (bf16_t*)(F.ws + WS_CHST); float* AE = (float*)(F.ws + WS_AEND);
    LAS char* lds = (LAS char*)F.lds; LAS float* acs = (LAS float*)(F.lds + S_ACS); LAS float* dtl = (LAS float*)(F.lds + S_DTL);
    const int lane = F.lane, wave = F.wave, r32 = lane & 31, hi = lane >> 5;
    for (int u = F.bid; u < NBATCH * NCHUNK * 2; u += F.G) {
        const int b = u / (NCHUNK * 2), c = (u >> 1) % NCHUNK, g = u & 1; const int row0 = b * TPB + c * 128;
        __syncthreads();
        ssd_tables(F, row0, g);
        stage_tile(F, XB + (size_t)row0 * XBC + 1024 + g * 128, XBC, lds + S_B, S_BSTR, 16);
        const int xl = F.tid >> 2, xpc = (F.tid & 3) * 16;
        u32x4 nx0, nx1;
        { const bf16_t* xp = XB + (size_t)(row0 + xl) * XBC + (g * 8) * 64 + xpc; nx0 = *(const u32x4*)xp; nx1 = *(const u32x4*)(xp + 8); }
#pragma unroll 1
        for (int hh = 0; hh < 8; ++hh) {
            const int head = g * 8 + hh; const u32x4 x0 = nx0, x1 = nx1;
            if (hh < 7) { const bf16_t* xp = XB + (size_t)(row0 + xl) * XBC + (head + 1) * 64 + xpc; nx0 = *(const u32x4*)xp; nx1 = *(const u32x4*)(xp + 8); }
#pragma unroll 1
            for (int dir = 0; dir < 2; ++dir) {
                const int combo = dir * 8 + hh;
                const float aend = acs[combo * 128 + (dir ? 0 : 127)];
                __syncthreads();
                { const float w = dtl[combo * 128 + xl] * __expf(aend - acs[combo * 128 + xl]);
                  *(LAS u32x4*)(lds + S_X + xl * S_XSTR + xpc * 2) = (u32x4){cvtpk(bflo(x0.x) * w, bfhi(x0.x) * w), cvtpk(bflo(x0.y) * w, bfhi(x0.y) * w), cvtpk(bflo(x0.z) * w, bfhi(x0.z) * w), cvtpk(bflo(x0.w) * w, bfhi(x0.w) * w)};
                  *(LAS u32x4*)(lds + S_X + xl * S_XSTR + xpc * 2 + 16) = (u32x4){cvtpk(bflo(x1.x) * w, bfhi(x1.x) * w), cvtpk(bflo(x1.y) * w, bfhi(x1.y) * w), cvtpk(bflo(x1.z) * w, bfhi(x1.z) * w), cvtpk(bflo(x1.w) * w, bfhi(x1.w) * w)}; }
                __syncthreads();
                const int pb = wave & 1, nb = wave >> 1; f32x16 acc = {};
#pragma unroll
                for (int ks = 0; ks < 8; ++ks) { const bf16x8 fa = frag_tr<false>(lds + S_X, S_XSTR, 16 * ks, 32 * pb, lane), fb = frag_tr<false>(lds + S_B, S_BSTR, 16 * ks, 32 * nb, lane);
                    acc = __builtin_amdgcn_mfma_f32_32x32x16_bf16(fb, fa, acc, 0, 0, 0); }
                bf16_t* out = CH + ((((size_t)b * 2 + dir) * 16 + head) * NCHUNK + c) * 8192;
#pragma unroll
                for (int i = 0; i < 4; ++i) *(u32x2*)(out + (32 * pb + r32) * 128 + 32 * nb + 8 * i + 4 * hi) = (u32x2){cvtpk(acc[4 * i], acc[4 * i + 1]), cvtpk(acc[4 * i + 2], acc[4 * i + 3])};
                if (F.tid == 0) AE[(((size_t)b * 2 + dir) * 16 + head) * NCHUNK + c] = aend;
            }
        }
    }
    __syncthreads();
}

__device__ __forceinline__ void p14_scan(const Frame& F) {
    const bf16_t* CH = (const bf16_t*)(F.ws + WS_CHST); const float* AE = (const float*)(F.ws + WS_AEND); bf16_t* ST = (bf16_t*)(F.ws + WS_STIN);
    const int total = NBATCH * 2 * 16 * 2048;
    for (int i = F.bid * NTHREADS + F.tid; i < total; i += F.G * NTHREADS) {
        const int seq = i >> 11, e4 = (i & 2047) * 4; const int dir = (seq >> 4) & 1;
        const bf16_t* ch = CH + (size_t)seq * NCHUNK * 8192 + e4; bf16_t* st = ST + (size_t)seq * NCHUNK * 8192 + e4; const float* ae = AE + (size_t)seq * NCHUNK;
        f32x4 s = (f32x4){0.f, 0.f, 0.f, 0.f};
        u32x2 nv[NCHUNK]; float av[NCHUNK];
#pragma unroll
        for (int k = 0; k < NCHUNK; ++k) { const int c = dir ? (k < 2 ? 1 - k : NCHUNK + 1 - k) : k; nv[k] = *(const u32x2*)(ch + (size_t)c * 8192); av[k] = ae[c]; }
        __builtin_amdgcn_sched_barrier(0);
#pragma unroll
        for (int k = 0; k < NCHUNK; ++k) { const int c = dir ? (k < 2 ? 1 - k : NCHUNK + 1 - k) : k;
            if (c >= 2) *(u32x2*)(st + (size_t)c * 8192) = (u32x2){cvtpk(s.x, s.y), cvtpk(s.z, s.w)};
            s = s * __expf(av[k]) + (f32x4){bflo(nv[k].x), bfhi(nv[k].x), bflo(nv[k].y), bfhi(nv[k].y)}; }
    }
}

__device__ __forceinline__ void p15_ssd_out(const Frame& F) {
    const bf16_t* XB = (const bf16_t*)(F.ws + WS_XBC); const bf16_t* ST = (const bf16_t*)(F.ws + WS_STIN); const bf16_t* Z = (const bf16_t*)(F.ws + WS_Z); bf16_t* GT = (bf16_t*)(F.ws + WS_O);
    LAS char* lds = (LAS char*)F.lds; LAS float* acs = (LAS float*)(F.lds + S_ACS); LAS float* dtl = (LAS float*)(F.lds + S_DTL);
    const int lane = F.lane, wave = F.wave, r32 = lane & 31, hi = lane >> 5; const int lb = wave & 3, ph = wave >> 2; const float* sd_ = inp(I_SD);
    for (int u = F.bid; u < NBATCH * 32 * 2; u += F.G) {
        const int b = u >> 6, c = 2 + ((u >> 1) & 31), g = u & 1; const int row0 = b * TPB + c * 128;
        __syncthreads();
        ssd_tables(F, row0, g);
        stage_tile(F, XB + (size_t)row0 * XBC + 1024 + g * 128, XBC, lds + S_B, S_BSTR, 16);
        stage_tile(F, XB + (size_t)row0 * XBC + 1280 + g * 128, XBC, lds + S_C, S_BSTR, 16);
        __syncthreads();
        unsigned Sp[4][8];
#pragma unroll
        for (int sb = 0; sb < 4; ++sb) { f32x16 S = {};
#pragma unroll
            for (int ks = 0; ks < 8; ++ks) S = __builtin_amdgcn_mfma_f32_32x32x16_bf16(frag_row(lds + S_B, S_BSTR, 32 * sb, 16 * ks, r32, hi), frag_row(lds + S_C, S_BSTR, 32 * lb, 16 * ks, r32, hi), S, 0, 0, 0);
#pragma unroll
            for (int i = 0; i < 8; ++i) Sp[sb][i] = cvtpk(S[2 * i], S[2 * i + 1]); }
        const int l = 32 * lb + r32;
        u32x4 px[2], pst[4];
#define S3_PREFETCH(hd_) do { const int t_ = opaque(F.tid); \
            _Pragma("unroll") for (int i_ = 0; i_ < 2; ++i_) { const int q_ = t_ + 512 * i_; px[i_] = *(const u32x4*)(XB + (size_t)(row0 + (q_ >> 3)) * XBC + (hd_) * 64 + (q_ & 7) * 8); } \
            _Pragma("unroll") for (int i_ = 0; i_ < 4; ++i_) { const int q_ = t_ + 512 * i_; const int dir_ = q_ >> 10, rr_ = (q_ >> 4) & 63, cc_ = q_ & 15; \
                pst[i_] = *(const u32x4*)(ST + ((((size_t)b * 2 + dir_) * 16 + (hd_)) * NCHUNK + c) * 8192 + rr_ * 128 + cc_ * 8); } } while (0)
        S3_PREFETCH(g * 8);
#pragma unroll 1
        for (int hh = 0; hh < 8; ++hh) {
            const int head = g * 8 + hh;
            __syncthreads();
            { const int t_ = opaque(F.tid);
#pragma unroll
              for (int i_ = 0; i_ < 2; ++i_) { const int q_ = t_ + 512 * i_; *(LAS u32x4*)(lds + S_X + (q_ >> 3) * S_XSTR + (q_ & 7) * 16) = px[i_]; }
#pragma unroll
              for (int i_ = 0; i_ < 4; ++i_) { const int q_ = t_ + 512 * i_; const int dir_ = q_ >> 10, rr_ = (q_ >> 4) & 63, cc_ = q_ & 15; *(LAS u32x4*)(lds + S_ST + dir_ * 64 * S_BSTR + rr_ * S_BSTR + cc_ * 16) = pst[i_]; } }
            __syncthreads();
            if (hh < 7) S3_PREFETCH(head + 1);
            f32x16 y = {};
#pragma unroll 1
            for (int dir = 0; dir < 2; ++dir) {
                const int combo = dir * 8 + hh; const float al = acs[combo * 128 + l];
                const int lloc = opaque(r32);
                f32x16 yd = {};
#pragma unroll
                for (int sb = 0; sb < 4; ++sb) {
                    if (dir ? (sb >= lb) : (sb <= lb)) {
                        f32x16 p; const bool diag = (sb == lb);
#pragma unroll
                        for (int r = 0; r < 16; ++r) { const int sl = crow(r, hi); const int s = 32 * sb + sl;
                            float dec = dtl[combo * 128 + s] * __expf(al - acs[combo * 128 + s]);
                            if (diag) { const bool ok = dir ? (sl >= lloc) : (sl <= lloc); dec = ok ? dec : 0.f; }
                            p[r] = ((r & 1) ? bfhi(Sp[sb][r >> 1]) : bflo(Sp[sb][r >> 1])) * dec; }
#pragma unroll
                        for (int ks = 0; ks < 2; ++ks) {
                            const u32x4 pw = (u32x4){cvtpk(p[8 * ks], p[8 * ks + 1]), cvtpk(p[8 * ks + 2], p[8 * ks + 3]), cvtpk(p[8 * ks + 4], p[8 * ks + 5]), cvtpk(p[8 * ks + 6], p[8 * ks + 7])};
                            yd = __builtin_amdgcn_mfma_f32_32x32x16_bf16(frag_tr<true>(lds + S_X, S_XSTR, 32 * sb + 16 * ks, 32 * ph, lane), __builtin_bit_cast(bf16x8, pw), yd, 0, 0, 0);
                        }
                    }
                }
                f32x16 zo = {};
#pragma unroll
                for (int ks = 0; ks < 8; ++ks) zo = __builtin_amdgcn_mfma_f32_32x32x16_bf16(frag_row(lds + S_ST + dir * 64 * S_BSTR, S_BSTR, 32 * ph, 16 * ks, r32, hi), frag_row(lds + S_C, S_BSTR, 32 * lb, 16 * ks, r32, hi), zo, 0, 0, 0);
                const float ea = __expf(al);
#pragma unroll
                for (int r = 0; r < 16; ++r) y[r] += yd[r] + ea * zo[r];
            }
            const float dsk = sd_[head] + sd_[16 + head];
            const size_t grow = (size_t)(row0 + l);
#pragma unroll
            for (int i = 0; i < 4; ++i) { const int p0 = 32 * ph + 8 * i + 4 * hi;
                const u32x2 xv = *(const LAS u32x2*)(lds + S_X + l * S_XSTR + p0 * 2); const u32x2 zv = *(const u32x2*)(Z + grow * D + head * 64 + p0);
                const float o0 = (y[4 * i] + dsk * bflo(xv.x)) * silu_f(bflo(zv.x)), o1 = (y[4 * i + 1] + dsk * bfhi(xv.x)) * silu_f(bfhi(zv.x));
                const float o2 = (y[4 * i + 2] + dsk * bflo(xv.y)) * silu_f(bflo(zv.y)), o3 = (y[4 * i + 3] + dsk * bfhi(xv.y)) * silu_f(bfhi(zv.y));
                *(u32x2*)(GT + grow * D + head * 64 + p0) = (u32x2){cvtpk(o0, o1), cvtpk(o2, o3)}; }
        }
    }
#undef S3_PREFETCH
    __syncthreads();
}

__device__ __forceinline__ void p16_merge(const Frame& F) {
    const int gw = F.bid * NWAVES + F.wave, NGW = F.G * NWAVES, lane = F.lane;
    const bf16_t* GT = (const bf16_t*)(F.ws + WS_O); bf16_t* A3 = (bf16_t*)(F.ws + WS_A3); const bf16_t* V = (const bf16_t*)(F.ws + WS_V);
    const float* sng_ = inp(I_SNORMG); const float* cdw_ = inp(I_CDWW); const float* clg_ = inp(I_CLNG); const float* clb_ = inp(I_CLNB);
    for (int q = gw; q < NBATCH * SEQ; q += NGW) {
        const int r = (q / SEQ) * TPB + CTXL + (q % SEQ);
        float x[16]; float s = 0.f;
#pragma unroll
        for (int j = 0; j < 4; ++j) { const u32x2 v = *(const u32x2*)(GT + (size_t)r * D + 4 * lane + 256 * j); x[4 * j] = bflo(v.x); x[4 * j + 1] = bfhi(v.x); x[4 * j + 2] = bflo(v.y); x[4 * j + 3] = bfhi(v.y); }
#pragma unroll
        for (int j = 0; j < 16; ++j) s += x[j] * x[j];
        const float inv = rsqrtf(wave_sum(s) * (1.0f / D) + EPS);
#pragma unroll
        for (int j = 0; j < 4; ++j) { const int c = 4 * lane + 256 * j; const f32x4 g = *(const f32x4*)(sng_ + c);
            *(u32x2*)(A3 + (size_t)r * 2048 + c) = (u32x2){cvtpk(x[4 * j] * inv * g.x, x[4 * j + 1] * inv * g.y), cvtpk(x[4 * j + 2] * inv * g.z, x[4 * j + 3] * inv * g.w)}; }
    }
    LAS float* cv = (LAS float*)F.lds;
    const int ch = 2 * F.tid;
    float w0[31], w1[31];
#pragma unroll
    for (int k = 0; k < 31; ++k) { const f32x2 w = *(const f32x2*)(cdw_ + (size_t)k * D + ch); w0[k] = w.x; w1[k] = w.y; }
    const f32x2 bias = *(const f32x2*)(inp(I_CDWB) + ch);
    for (int u = F.bid; u < NBATCH * (SEQ / 16); u += F.G) {
        const int b = u / (SEQ / 16), t0 = (u % (SEQ / 16)) * 16; const size_t rbase = (size_t)b * TPB + CTXL;
        float a0[16], a1[16];
#pragma unroll
        for (int j = 0; j < 16; ++j) { a0[j] = bias.x; a1[j] = bias.y; }
        unsigned xin[46];
#pragma unroll
        for (int i = 0; i < 46; ++i) { const int t = t0 + i - 15; const int tc = t < 0 ? 0 : (t >= SEQ ? SEQ - 1 : t); xin[i] = *(const unsigned*)(V + (rbase + tc) * D + ch); }
        __builtin_amdgcn_sched_barrier(0);
#pragma unroll
        for (int i = 0; i < 46; ++i) { const int t = t0 + i - 15; const unsigned xv = (t >= 0 && t < SEQ) ? xin[i] : 0u; const float x0 = bflo(xv), x1 = bfhi(xv);
#pragma unroll
            for (int j = 0; j < 16; ++j) { const int k = i - j; if (k >= 0 && k < 31) { a0[j] += w0[k] * x0; a1[j] += w1[k] * x1; } } }
        __syncthreads();
#pragma unroll
        for (int j = 0; j < 16; ++j) *(LAS f32x2*)(cv + j * 1024 + ch) = (f32x2){a0[j], a1[j]};
        __syncthreads();
#pragma unroll
        for (int jj = 0; jj < 2; ++jj) { const int j = F.wave * 2 + jj; f32x4 v[4]; float s = 0.f;
#pragma unroll
            for (int k = 0; k < 4; ++k) { v[k] = *(const LAS f32x4*)(cv + j * 1024 + 4 * lane + 256 * k); s += (v[k].x + v[k].y) + (v[k].z + v[k].w); }
            const float mu = wave_sum(s) * (1.0f / D); float s2 = 0.f;
#pragma unroll
            for (int k = 0; k < 4; ++k) { v[k] = v[k] - mu; s2 += (v[k].x * v[k].x + v[k].y * v[k].y) + (v[k].z * v[k].z + v[k].w * v[k].w); }
            const float rstd = rsqrtf(wave_sum(s2) * (1.0f / D) + EPS);
            bf16_t* orow = A3 + (rbase + t0 + j) * 2048 + 1024;
#pragma unroll
            for (int k = 0; k < 4; ++k) { const int c = 4 * lane + 256 * k; const f32x4 g = *(const f32x4*)(clg_ + c), bb = *(const f32x4*)(clb_ + c);
                const float y0 = silu_f(v[k].x * rstd * g.x + bb.x), y1 = silu_f(v[k].y * rstd * g.y + bb.y), y2 = silu_f(v[k].z * rstd * g.z + bb.z), y3 = silu_f(v[k].w * rstd * g.w + bb.w);
                *(u32x2*)(orow + c) = (u32x2){cvtpk(y0, y1), cvtpk(y2, y3)}; }
        }
    }
    __syncthreads();
}
#ifndef MK_PER_PHASE
#define MK_PER_PHASE 0
#endif
#ifndef MK_LAST_PHASE
#define MK_LAST_PHASE 22
#endif
#ifndef MK_MOE_SP2
#define MK_MOE_SP2 1
#endif
constexpr int N_PHASES = 22;
constexpr int TAB_OFF = 131072;
constexpr int MOE_KB = MK_FP8 ? 1024 : 2048;

__global__ void __launch_bounds__(NTHREADS, 2) fwd_kernel(Args args) {
    extern __shared__ __attribute__((aligned(16))) unsigned char lds_raw[];
    Frame F;
    F.lds = (LAS unsigned char*)lds_raw; F.ws = args.ws; F.ctl = (unsigned*)(args.ws + WS_CTL);
    F.tid = threadIdx.x; F.lane = F.tid & 63; F.wave = __builtin_amdgcn_readfirstlane(F.tid >> 6); F.G = gridDim.x; F.bid = blockIdx.x; F.x = args.in[I_X]; F.ctx = args.in[I_CTX];
    volatile LAS unsigned* MISC = (volatile LAS unsigned*)(F.lds + MISC_OFF);
    if (F.tid < 64) MISC[F.tid] = 0u;
    __syncthreads();
    XcdBarrier bar; bar.bar = F.ctl + CW_BAR; bar.x = 0; bar.st = nullptr;
    if (!MK_PER_PHASE) bar = xcd_barrier_post(F.ctl + CW_BAR, MISC + 8);
    const int lo = args.ph_lo, hi = args.ph_hi;
#ifndef MK_ONLY
#define MK_ONLY -1
#endif
#define IN(k) ((MK_ONLY < 0 || MK_ONLY == (k)) && lo <= (k) && (k) < hi)
#ifndef MK_REP_MASK
#define MK_REP_MASK 0
#endif
#define REP(k) _Pragma("unroll") for (int _rep = 0; _rep < 1 + ((MK_REP_MASK >> (k)) & 1); __syncthreads(), ++_rep)
#ifndef MK_BAR2
#define MK_BAR2 0
#endif
#define SEAM(k) do { if (IN(k) && IN((k) + 1)) { xcd_barrier(bar); if (MK_BAR2) xcd_barrier(bar); } } while (0)
    unsigned* cnt0 = F.ctl + CW_CNT0; unsigned* cnt1 = F.ctl + CW_CNT1;
    LAS int* tab = (LAS int*)(F.lds + TAB_OFF);

    if (IN(0)) REP(0) { F.tid = fresh_tid(F.wave); F.lane = F.tid & 63; p0_prologue(F); } SEAM(0);
    if (IN(1)) REP(1) { F.tid = fresh_tid(F.wave); F.lane = F.tid & 63; p1_norm_mod(F); } SEAM(1);
    if (IN(2)) REP(2) { F.tid = fresh_tid(F.wave); F.lane = F.tid & 63;
        DenseOrder S{(const char*)(F.ws + WS_H), (const char*)(F.ws + WS_WAIN), 2048, MR / 256, ATTN_INP / 256, F.G, F.bid, false, 0, 0, 0, 0, 0u, 51};
        EpiBf16 E{(bf16_t*)(F.ws + WS_U0), ATTN_INP, F.ctl + CW_RDY2};
        pg8::gemm_phase<EpiBf16, DenseOrder, false>(F.lds, 2048, S, E, F.tid);
    }
    if (IN(3)) REP(3) { F.tid = fresh_tid(F.wave); F.lane = F.tid & 63; p3_attn_post(F, F.ctl + CW_RDY2); } SEAM(3);
    if (IN(4)) REP(4) { F.tid = fresh_tid(F.wave); F.lane = F.tid & 63;
        DenseOrder S{(const char*)(F.ws + WS_CQKV), (const char*)(F.ws + WS_WUP), UPK * 2, MR / 256, UPN / 256, F.G, F.bid, false, 0, 0, 0, 0, 0u};
        EpiUp E{(bf16_t*)(F.ws + WS_QM), (bf16_t*)(F.ws + WS_KM), (bf16_t*)(F.ws + WS_VM)};
        pg8::gemm_phase<EpiUp, DenseOrder, false>(F.lds, UPK * 2, S, E, F.tid);
    } SEAM(4);
    if (IN(5)) REP(5) { F.tid = fresh_tid(F.wave); F.lane = F.tid & 63; p5_attention(F); } SEAM(5);
    if (IN(6)) REP(6) { F.tid = fresh_tid(F.wave); F.lane = F.tid & 63;
        DenseOrder S{(const char*)(F.ws + WS_O), (const char*)(F.ws + WS_WAOUT), 2048, MR / 256, 4, F.G, F.bid, false, 0, 0, 0, 0, 0u, 64};
        EpiResid<true> E{F, nullptr, (bf16_t*)(F.ws + WS_X1), 0, F.ctl + CW_RDY};
        pg8::gemm_phase<EpiResid<true>, DenseOrder, false>(F.lds, 2048, S, E, F.tid);
    }
    if (IN(7)) REP(7) { F.tid = fresh_tid(F.wave); F.lane = F.tid & 63; p7_router(F, 0, (const bf16_t*)(F.ws + WS_X1), false, F.ctl + CW_RDY, (((MK_REP_MASK >> 7) & 1) && _rep == 0) ? F.ctl + CW_CNT0 + 8192 : cnt0); } SEAM(7);
    if (IN(8)) REP(8) { F.tid = fresh_tid(F.wave); F.lane = F.tid & 63;
        moe_table(F, cnt0, tab);
        MoeOrder S{tab, (const char*)(F.ws + WS_X8), (const char*)(F.ws + WS_WGU), MOE_KB, 8, F.G, F.bid, true, (size_t)2048 * MOE_KB, 1};
        EpiSwiglu E{(unsigned char*)(F.ws + WS_ACT), inp(I_BGU)};
        pg8::gemm_phase<EpiSwiglu, MoeOrder, false, MK_FP8 != 0, 0, 0, MK_MOE_SP2 != 0, true>(F.lds, MOE_KB, S, E, F.tid);
    } SEAM(8);
    if (IN(9)) REP(9) { F.tid = fresh_tid(F.wave); F.lane = F.tid & 63;
        moe_table(F, cnt0, tab);
        MoeOrder S{tab, (const char*)(F.ws + WS_ACT), (const char*)(F.ws + WS_WDN), MOE_KB, 4, F.G, F.bid, false, (size_t)1024 * MOE_KB, 0};
        EpiYs E{(unsigned char*)(F.ws + WS_YS), inp(I_BDN)};
        pg8::gemm_phase<EpiYs, MoeOrder, false, MK_FP8 != 0, 0, 0, MK_MOE_SP2 != 0, true>(F.lds, MOE_KB, S, E, F.tid);
    } SEAM(9);
    if (IN(10)) REP(10) { F.tid = fresh_tid(F.wave); F.lane = F.tid & 63; p_combine<false>(F, 0, (const bf16_t*)(F.ws + WS_X1), (void*)(F.ws + WS_X2), cnt0); } SEAM(10);
    if (IN(11)) REP(11) { F.tid = fresh_tid(F.wave); F.lane = F.tid & 63;
        DenseOrder S{(const char*)(F.ws + WS_H), (const char*)(F.ws + WS_WSIN), 2048, 64, SSM_INP / 256, F.G, F.bid, true, 10, 2560, 3584, 8, (0x3fu << 4) | (1u << 18)};
        EpiSsmIn E{(bf16_t*)(F.ws + WS_Z), (bf16_t*)(F.ws + WS_XBCRAW), (bf16_t*)(F.ws + WS_V), (float*)(F.ws + WS_DTRAW)};
        pg8::gemm_phase<EpiSsmIn, DenseOrder, false>(F.lds, 2048, S, E, F.tid);
    } SEAM(11);
    if (IN(12)) REP(12) { F.tid = fresh_tid(F.wave); F.lane = F.tid & 63; p12_ssd_prep(F); } SEAM(12);
    if (IN(13)) REP(13) { F.tid = fresh_tid(F.wave); F.lane = F.tid & 63; p13_chunk_states(F); } SEAM(13);
    if (IN(14)) REP(14) { F.tid = fresh_tid(F.wave); F.lane = F.tid & 63; p14_scan(F); } SEAM(14);
    if (IN(15)) REP(15) { F.tid = fresh_tid(F.wave); F.lane = F.tid & 63; p15_ssd_out(F); } SEAM(15);
    if (IN(16)) REP(16) { F.tid = fresh_tid(F.wave); F.lane = F.tid & 63; p16_merge(F); } SEAM(16);
    if (IN(17)) REP(17) { F.tid = fresh_tid(F.wave); F.lane = F.tid & 63;
        DenseOrder S{(const char*)(F.ws + WS_A3), (const char*)(F.ws + WS_WSOUT), 4096, 64, 4, F.G, F.bid, true, 0, 0, 0, 0, 0u};
        EpiResid<false> E{F, (const bf16_t*)(F.ws + WS_X2), (bf16_t*)(F.ws + WS_X1), 1, nullptr};
        pg8::gemm_phase<EpiResid<false>, DenseOrder, false>(F.lds, 4096, S, E, F.tid);
    } SEAM(17);
    if (IN(18)) REP(18) { F.tid = fresh_tid(F.wave); F.lane = F.tid & 63; p7_router(F, 1, (const bf16_t*)(F.ws + WS_X1), true, nullptr, (((MK_REP_MASK >> 18) & 1) && _rep == 0) ? F.ctl + CW_CNT0 + 12288 : cnt1); } SEAM(18);
    if (IN(19)) REP(19) { F.tid = fresh_tid(F.wave); F.lane = F.tid & 63;
        moe_table(F, cnt1, tab);
        MoeOrder S{tab, (const char*)(F.ws + WS_X8), (const char*)(F.ws + WS_WGU + (size_t)32 * 2048 * MOE_KB), MOE_KB, 8, F.G, F.bid, true, (size_t)2048 * MOE_KB, 1};
        EpiSwiglu E{(unsigned char*)(F.ws + WS_ACT), inp(I_BGU) + (size_t)32 * 2048};
        pg8::gemm_phase<EpiSwiglu, MoeOrder, false, MK_FP8 != 0, 0, 0, MK_MOE_SP2 != 0, true>(F.lds, MOE_KB, S, E, F.tid);
    } SEAM(19);
    if (IN(20)) REP(20) { F.tid = fresh_tid(F.wave); F.lane = F.tid & 63;
        moe_table(F, cnt1, tab);
        MoeOrder S{tab, (const char*)(F.ws + WS_ACT), (const char*)(F.ws + WS_WDN + (size_t)32 * 1024 * MOE_KB), MOE_KB, 4, F.G, F.bid, false, (size_t)1024 * MOE_KB, 0};
        EpiYs E{(unsigned char*)(F.ws + WS_YS), inp(I_BDN) + (size_t)32 * 1024};
        pg8::gemm_phase<EpiYs, MoeOrder, false, MK_FP8 != 0, 0, 0, MK_MOE_SP2 != 0, true>(F.lds, MOE_KB, S, E, F.tid);
    } SEAM(20);
    if (IN(21)) REP(21) { F.tid = fresh_tid(F.wave); F.lane = F.tid & 63; p_combine<true>(F, 1, (const bf16_t*)(F.ws + WS_X1), (void*)args.out, cnt1); }
#undef IN
#undef SEAM
}

extern "C" void kernel_launch(void* const* d_in, const int* in_sizes, int n_in, void* d_out, int out_size, void* d_ws, size_t ws_size, hipStream_t stream) {
    static int grid = 0;
    if (grid == 0) {
        if (n_in != 34 || out_size != NBATCH * SEQ * D || ws_size < WS_END) { fprintf(stderr, "kernel_launch: unexpected problem (n_in %d, out %d, ws %zu < %zu); nothing launched\n", n_in, out_size, ws_size, (size_t)WS_END); grid = -1; return; }
        int dev = 0, cus = 0, per_cu = 0;
        if (hipGetDevice(&dev) != hipSuccess || hipDeviceGetAttribute(&cus, hipDeviceAttributeMultiprocessorCount, dev) != hipSuccess) { grid = -1; return; }
        if (hipFuncSetAttribute((const void*)fwd_kernel, hipFuncAttributeMaxDynamicSharedMemorySize, LDS_BYTES) != hipSuccess) { fprintf(stderr, "kernel_launch: hipFuncSetAttribute failed\n"); grid = -1; return; }
        if (hipOccupancyMaxActiveBlocksPerMultiprocessor(&per_cu, (const void*)fwd_kernel, NTHREADS, LDS_BYTES) != hipSuccess || per_cu < 1) { fprintf(stderr, "kernel_launch: occupancy query says %d\n", per_cu); }
        (void)hipGetLastError();
        grid = cus;
    }
    if (grid < 0) return;
    (void)hipMemsetAsync((char*)d_ws + WS_CTL, 0, CTL_ZERO_BYTES, stream);
    Args a{};
    for (int i = 0; i < 34; ++i) a.in[i] = (const float*)d_in[i];
    a.out = (float*)d_out; a.ws = (unsigned char*)d_ws;
#if MK_PER_PHASE
    for (int p = 0; p < MK_LAST_PHASE; ++p) { a.ph_lo = p; a.ph_hi = p + 1; hipLaunchKernelGGL(fwd_kernel, dim3(grid), dim3(NTHREADS), LDS_BYTES, stream, a); }
#else
    a.ph_lo = 0; a.ph_hi = MK_LAST_PHASE;
    hipLaunchKernelGGL(fwd_kernel, dim3(grid), dim3(NTHREADS), LDS_BYTES, stream, a);
#endif
    const hipError_t le = hipPeekAtLastError();
    if (le != hipSuccess) fprintf(stderr, "kernel_launch: launch failed: %s\n", hipGetErrorName(le));
}
```

```cpp
#include <hip/hip_runtime.h>
#include <cstdio>
#include <cstdint>

#define LAS __attribute__((address_space(3)))
#define GAS __attribute__((address_space(1)))
typedef unsigned short bf16_t;
typedef short bf16x8 __attribute__((ext_vector_type(8)));
typedef short s16x4 __attribute__((ext_vector_type(4)));
typedef float f32x2 __attribute__((ext_vector_type(2)));
typedef float f32x4 __attribute__((ext_vector_type(4)));
typedef float f32x16 __attribute__((ext_vector_type(16)));
typedef unsigned u32x2 __attribute__((ext_vector_type(2)));
typedef unsigned u32x4 __attribute__((ext_vector_type(4)));
typedef __bf16 bf16x2_t __attribute__((ext_vector_type(2)));

constexpr int D = 1024, NBATCH = 4, SEQ = 4096, CTXL = 256, TPB = SEQ + CTXL  , MR = NBATCH * TPB  ;
constexpr float EPS = 1e-6f;
constexpr int ATTN_IN = 1184, ATTN_INP = 1280, UPK = 384, UPN = 1792;
constexpr int SSM_IN = 4624, SSM_INP = 4864, XBC = 1536;
constexpr int NE = 32, TOPK = 4, MAXROWS = 77824;
constexpr int NCHUNK = 34;
constexpr float LOG2E = 1.4426950408889634f;
constexpr float C2M = 0.10206207261596577f * LOG2E;
constexpr float C2G = 0.125f * LOG2E;

constexpr size_t MiB = 1u << 20;
constexpr size_t WS_CTL = 0, CTL_ZERO_BYTES = 1 * MiB;
constexpr size_t WS_MOD = 1 * MiB;
constexpr size_t WS_ROPEM = 2 * MiB;
constexpr size_t WS_ROPEG = 3 * MiB;
constexpr size_t WS_WAIN = 4 * MiB;
constexpr size_t WS_WUP = 7 * MiB;
constexpr size_t WS_WAOUT = 9 * MiB;
constexpr size_t WS_WSIN = 11 * MiB;
constexpr size_t WS_WSOUT = 21 * MiB;
constexpr size_t WS_WGU = 32 * MiB;
constexpr size_t WS_WDN = 160 * MiB;
constexpr size_t WS_H = 224 * MiB;
constexpr size_t WS_X1 = 260 * MiB;
constexpr size_t WS_X2 = 332 * MiB;
constexpr size_t WS_O = 404 * MiB;
constexpr size_t WS_U0 = 440 * MiB;
constexpr size_t WS_Z = WS_U0, WS_V = WS_U0 + 36 * MiB;
constexpr size_t WS_CQKV = 528 * MiB;
constexpr size_t WS_QM = 542 * MiB, WS_KM = 568 * MiB;
constexpr size_t WS_VM = 594 * MiB, WS_QG = 612 * MiB;
constexpr size_t WS_KG = 630 * MiB, WS_VG = 636 * MiB;
constexpr size_t WS_TOPE = 642 * MiB, WS_TOPP = 643 * MiB, WS_TOPW = 644 * MiB;
constexpr size_t WS_ACT = 645 * MiB;
constexpr size_t WS_YS = 721 * MiB;
constexpr size_t WS_XBCRAW = 873 * MiB;
constexpr size_t WS_XBC = 925 * MiB;
constexpr size_t WS_DTRAW = 977 * MiB;
constexpr size_t WS_DT = 979 * MiB;
constexpr size_t WS_CHST = 982 * MiB;
constexpr size_t WS_STIN = 1118 * MiB;
constexpr size_t WS_AEND = 1186 * MiB;
constexpr size_t WS_A3 = 1187 * MiB;
constexpr size_t WS_X8 = 1257 * MiB;
constexpr size_t WS_END = 1801 * MiB;
constexpr int CW_BAR = 4096;
constexpr int CW_RDY = 32768;
constexpr int CW_RDY2 = 32768 + 8192;
constexpr int CW_CNT0 = 8192, CW_CNT1 = 8192 + 4096;

constexpr int NWAVES = 8, NTHREADS = 512;
constexpr int LDS_BYTES = 163840;
constexpr int MISC_OFF = 163840 - 256;

#define MK_FP8 1
constexpr float FP8_SW = 64.f, FP8_SH = 16.f, FP8_SA = 4.f, FP8_SY = 16.f;
constexpr int E8_G1 = 0x7a7a7a7a, E8_G2 = 0x7b7b7b7b;
__device__ __forceinline__ unsigned cvtpk(float lo, float hi) { f32x2 v = {lo, hi}; bf16x2_t b = __builtin_convertvector(v, bf16x2_t); return __builtin_bit_cast(unsigned, b); }
__device__ __forceinline__ float clamp448(float x) { return __builtin_amdgcn_fmed3f(x, -448.f, 448.f); }
__device__ __forceinline__ unsigned pk4_fp8(float a, float b, float c, float d) {
    int w = __builtin_amdgcn_cvt_pk_fp8_f32(clamp448(a), clamp448(b), 0, false); w = __builtin_amdgcn_cvt_pk_fp8_f32(clamp448(c), clamp448(d), w, true); return (unsigned)w; }
__device__ __forceinline__ unsigned pk4_fp8_nc(float a, float b, float c, float d) {
    int w = __builtin_amdgcn_cvt_pk_fp8_f32(a, b, 0, false); w = __builtin_amdgcn_cvt_pk_fp8_f32(c, d, w, true); return (unsigned)w; }
__device__ __forceinline__ float bf2f(unsigned short b) { return __uint_as_float(((unsigned)b) << 16); }
__device__ __forceinline__ float bflo(unsigned w) { return __uint_as_float(w << 16); }
__device__ __forceinline__ float bfhi(unsigned w) { return __uint_as_float(w & 0xffff0000u); }
__device__ __forceinline__ float wave_sum(float v) {
#pragma unroll
    for (int o = 1; o < 64; o <<= 1) v += __shfl_xor(v, o);
    return v;
}
__device__ __forceinline__ float sigmoid_f(float x) { return __builtin_amdgcn_rcpf(1.0f + __builtin_amdgcn_exp2f(x * -LOG2E)); }
__device__ __forceinline__ float silu_f(float x) { return x * sigmoid_f(x); }
#define LDS_WAIT() asm volatile("s_waitcnt lgkmcnt(0)" ::: "memory")
#define VM_WAIT() asm volatile("s_waitcnt vmcnt(0)" ::: "memory")

#define XB_TMO      128
#define XB_XCNT(j)  (256  + 64 * (j))
#define XB_XSUB(j)  (1280 + 64 * (j))
#define XB_XGEN(j)  (2304 + 64 * (j))
#define XB_TOP      3328
#define XB_TOPGEN   3392
#define XCD_BAR_WORDS 3456
#define XB_SPIN_CAP (1u << 18)
__device__ __forceinline__ unsigned xb_ld(unsigned* p)              { return __hip_atomic_load(p, __ATOMIC_RELAXED, __HIP_MEMORY_SCOPE_AGENT); }
__device__ __forceinline__ unsigned xb_add(unsigned* p, unsigned v) { return __hip_atomic_fetch_add(p, v, __ATOMIC_RELAXED, __HIP_MEMORY_SCOPE_AGENT); }
__device__ __forceinline__ unsigned xb_xcc_id() { return (unsigned)__builtin_amdgcn_s_getreg((3 << 11) | 20) & 0xFu; }
#define XB_SPIN(cond, bar) do { unsigned _sp = 0; while (cond) { __builtin_amdgcn_s_sleep(1); \
    if ((++_sp & 255u) == 0u) { if (xb_ld(&(bar)[XB_TMO])) break; if (_sp > XB_SPIN_CAP) { atomicAdd(&(bar)[XB_TMO], 1u); break; } } } } while (0)
struct XcdBarrier { unsigned* bar; unsigned x; volatile LAS unsigned* st; };
__device__ __forceinline__ XcdBarrier xcd_barrier_post(unsigned* bar, volatile LAS unsigned* st) {
    XcdBarrier b; b.bar = bar; b.x = xb_xcc_id(); b.st = st;
    if (threadIdx.x == 0) (void)xb_add(&bar[XB_XCNT(b.x)], 1u);
    return b;
}
__device__ __forceinline__ void xcd_barrier_complete(unsigned* bar, unsigned x, unsigned& nloc, unsigned& nx) {
    const unsigned G = gridDim.x * gridDim.y * gridDim.z;
    unsigned sum, cnt, mine, sp = 0u;
    for (;;) {
        sum = 0u; cnt = 0u; mine = 0u;
#pragma unroll
        for (unsigned j = 0; j < 16; ++j) { const unsigned c = xb_ld(&bar[XB_XCNT(j)]); sum += c; cnt += (c > 0u) ? 1u : 0u; mine = (j == x) ? c : mine; }
        if (sum == G) break;
        __builtin_amdgcn_s_sleep(1);
        if ((++sp & 255u) == 0u) { if (xb_ld(&bar[XB_TMO])) break; if (sp > XB_SPIN_CAP) { atomicAdd(&bar[XB_TMO], 1u); break; } }
    }
    nloc = mine > 0u ? mine : 1u; nx = cnt > 0u ? cnt : 1u;
}
__device__ __forceinline__ void xcd_barrier(const XcdBarrier& b) {
    asm volatile("s_waitcnt vmcnt(0)" ::: "memory");
    __syncthreads();
    if (threadIdx.x == 0) {
        unsigned* bar = b.bar;
        __builtin_amdgcn_s_waitcnt(0);
        unsigned nloc = b.st[0], nx = b.st[1];
        if (nloc == 0u) { xcd_barrier_complete(bar, b.x, nloc, nx); b.st[0] = nloc; b.st[1] = nx; }
        const unsigned old = xb_add(&bar[XB_XSUB(b.x)], 1u);
        const unsigned gen = old / nloc;
        if (old + 1u == (gen + 1u) * nloc) {
            __builtin_amdgcn_fence(__ATOMIC_RELEASE, "agent");
            asm volatile("s_waitcnt vmcnt(0)" ::: "memory");
            const unsigned og = xb_add(&bar[XB_TOP], 1u);
            const unsigned tg = og / nx;
            if (og + 1u == (tg + 1u) * nx) xb_add(&bar[XB_TOPGEN], 1u);
            else XB_SPIN(xb_ld(&bar[XB_TOPGEN]) == tg, bar);
            __builtin_amdgcn_fence(__ATOMIC_ACQUIRE, "agent");
            xb_add(&bar[XB_XGEN(b.x)], 1u);
            asm volatile("s_waitcnt vmcnt(0)" ::: "memory");
        } else {
            XB_SPIN(xb_ld(&bar[XB_XGEN(b.x)]) == gen, bar);
            __builtin_amdgcn_fence(__ATOMIC_ACQUIRE, "agent");
            asm volatile("s_waitcnt vmcnt(0)" ::: "memory");
        }
    }
    __syncthreads();
}

__device__ __forceinline__ void store_wt16(void* p, u32x4 v) { asm volatile("global_store_dwordx4 %0, %1, off sc1\n\ts_nop 1" :: "v"(p), "v"(v) : "memory"); }
__device__ __forceinline__ void wait_rows_ready(unsigned* rdy, int r0, int r1, unsigned want) {
    if (r1 <= r0) return;
    for (int t = r0 >> 8; t <= (r1 - 1) >> 8; ++t) { unsigned sp = 0u; while (xb_ld(rdy + 64 * t) < want) { __builtin_amdgcn_s_sleep(1); if (++sp > (1u << 21)) break; } }
    __builtin_amdgcn_fence(__ATOMIC_ACQUIRE, "agent");
}

struct Args { const float* in[34]; float* out; unsigned char* ws; int ph_lo, ph_hi; };
struct Frame {
    LAS unsigned char* lds;
    unsigned char* ws;
    unsigned* ctl;
    int tid, lane, wave, G, bid;
    const float* x; const float* ctx;
};
enum { I_X = 0, I_C, I_CTX, I_CCTX, I_WMOD, I_BMOD, I_NORMG, I_AWIN, I_GCQ, I_WUQ, I_GCKV, I_WUKV, I_GQ, I_GK, I_AWOUT, I_SWIN, I_SCONVW, I_SCONVB, I_ALOG, I_DTBIAS, I_SD, I_SNORMG,
       I_CDWW, I_CDWB, I_CLNG, I_CLNB, I_SWOUT, I_WROUTER, I_BROUTER, I_WGU, I_BGU, I_WDN, I_BDN, I_FINALG };

__device__ __forceinline__ int fresh_tid(int wave) { int l; asm volatile("v_mbcnt_lo_u32_b32 %0, -1, 0\n\tv_mbcnt_hi_u32_b32 %0, -1, %0" : "=v"(l)); return wave * 64 + l; }
__device__ __forceinline__ const float* inp(int i) {
    unsigned long long p; asm volatile("s_load_dwordx2 %0, %1, %2\n\ts_waitcnt lgkmcnt(0)" : "=s"(p) : "s"(__builtin_amdgcn_kernarg_segment_ptr()), "n"(i * 8));
    return (const float*)(GAS const float*)p; }
__device__ __forceinline__ const float* src_row(const Frame& F, int r) {
    const int b = r / TPB, tp = r - b * TPB;
    return tp < CTXL ? F.ctx + ((size_t)b * CTXL + tp) * D : F.x + ((size_t)b * SEQ + (tp - CTXL)) * D;
}
__device__ __forceinline__ const float* mod_vec(const Frame& F, int layer, int r, int k) {
    const int b = r / TPB, tp = r - b * TPB; const int v = tp < CTXL ? 4 : b;
    return (const float*)(F.ws + WS_MOD) + ((size_t)(layer * 5 + v) * 6 + k) * D;
}
#ifndef MK_DENSE_SP2
#define MK_DENSE_SP2 1
#endif
namespace pg8 {
constexpr int BM = 256, BK = 64, HALF = 128, HTB = HALF * BK * 2, STAGE_BYTES = 8 * HTB;
__host__ __device__ __forceinline__ int lds_byte(int r, int c) { const int st = (r >> 4) * 2 + (c >> 5), rr = r & 15, cc = c & 31, ob = rr * 64 + cc * 2; return st * 1024 + (ob ^ (((ob >> 9) & 1) << 5)); }
__host__ __device__ __forceinline__ void stage_rc(int b, int& R, int& C) { const int st = b / 1024, sb = b % 1024, swz = sb ^ (((sb >> 9) & 1) << 5); R = (st >> 1) * 16 + swz / 64; C = (st & 1) * 32 + (swz % 64) / 2; }
__host__ __device__ __forceinline__ int perm32(int rho) { const int n = rho >> 4, i = rho & 15; return 8 * (i >> 2) + 4 * n + (i & 3); }

__device__ __forceinline__ const char* uni64(const char* p) {
    const unsigned lo = __builtin_amdgcn_readfirstlane((unsigned)(uintptr_t)p), hi = __builtin_amdgcn_readfirstlane((unsigned)((uintptr_t)p >> 32)); return (const char*)(((uintptr_t)hi << 32) | (uintptr_t)lo); }
__device__ __forceinline__ int pg8_lane() { int l; asm volatile("v_mbcnt_lo_u32_b32 %0, -1, 0\n\tv_mbcnt_hi_u32_b32 %0, -1, %0" : "=v"(l)); return l; }
struct GUnit {
    const char* A;
    const char* B0; const char* B1;
    const int* rows; int nrows;
    int row0;
    int col0, col1;
    int e;
};

template <class Epi, class Sched, bool GATHER, bool FP8 = false, int SCB = 0x7f7f7f7f, int SCA = 0x7f7f7f7f, bool SP2 = (MK_DENSE_SP2 != 0), bool ALIGN_EPI = true>
__device__ __forceinline__ void gemm_phase(LAS unsigned char* lds, const int KB, const Sched& S, const Epi& E, const int tid) {
    const int wid = __builtin_amdgcn_readfirstlane(tid >> 6), lane = tid & 63, wr = wid >> 2, wc = wid & 3, fr = lane & 15, fq = lane >> 4;
    const int nt = KB / 128;
    unsigned voffA, voffB;
    { int R, C; stage_rc(tid * 16, R, C); voffA = (unsigned)(R * KB + C * 2); voffB = (unsigned)(((R & ~31) + perm32(R & 31)) * KB + C * 2); }
    const size_t hoff = (size_t)HALF * KB, ioff = (size_t)64 * KB;
    const size_t kstep = (size_t)(BK * 2);
    const unsigned ldsw = (unsigned)wid * 1024u;
    const int aoff = lds_byte(wr * 64 + fr, fq * 8), boff = lds_byte(wc * 32 + fr, fq * 8);
    constexpr int KSL = 1024;
#define PG8_SA(b, h) (((b) * 2 + (h)) * HTB)
#define PG8_SB(b, h) ((4 + (b) * 2 + (h)) * HTB)
#define PG8_STAGE(bufoff, gbase, voff) do { _Pragma("unroll") for (int _i = 0; _i < 2; ++_i) { const char* _ub = uni64((const char*)(gbase) + _i * ioff); \
        unsigned _vo = (voff); asm volatile("" : "+v"(_vo));        \
        __builtin_amdgcn_global_load_lds((const unsigned*)(_ub + _vo), (LAS unsigned*)(lds + (bufoff) + ldsw + _i * 8192), 16, 0, 0); } } while (0)
#define PG8_LDA(dst, b, h) do { _Pragma("unroll") for (int m = 0; m < 4; ++m) _Pragma("unroll") for (int k = 0; k < 2; ++k) dst[m][k] = *(const LAS bf16x8*)(lds + PG8_SA(b, h) + aoff + m * 2048 + k * KSL); } while (0)
#define PG8_LDB(dst, b, h) do { _Pragma("unroll") for (int n = 0; n < 2; ++n) _Pragma("unroll") for (int k = 0; k < 2; ++k) dst[n][k] = *(const LAS bf16x8*)(lds + PG8_SB(b, h) + boff + n * 2048 + k * KSL); } while (0)
#define PG8_MMA(ai, bj, At, Bt) do { __builtin_amdgcn_s_setprio(1); _Pragma("unroll") for (int m = 0; m < 4; ++m) _Pragma("unroll") for (int n = 0; n < 2; ++n) { \
        if (FP8) { typedef int v4i_t __attribute__((ext_vector_type(4))); typedef int v8i_t __attribute__((ext_vector_type(8))); \
            const v4i_t b0_ = __builtin_bit_cast(v4i_t, Bt[n][0]), b1_ = __builtin_bit_cast(v4i_t, Bt[n][1]), a0_ = __builtin_bit_cast(v4i_t, At[m][0]), a1_ = __builtin_bit_cast(v4i_t, At[m][1]); \
            acc[ai][bj][m][n] = __builtin_amdgcn_mfma_scale_f32_16x16x128_f8f6f4((v8i_t){b0_[0], b0_[1], b0_[2], b0_[3], b1_[0], b1_[1], b1_[2], b1_[3]}, (v8i_t){a0_[0], a0_[1], a0_[2], a0_[3], a1_[0], a1_[1], a1_[2], a1_[3]}, acc[ai][bj][m][n], 0, 0, 0, SCB, 0, SCA); } \
        else { _Pragma("unroll") for (int k = 0; k < 2; ++k) acc[ai][bj][m][n] = __builtin_amdgcn_mfma_f32_16x16x32_bf16(Bt[n][k], At[m][k], acc[ai][bj][m][n], 0, 0, 0); } } \
        __builtin_amdgcn_s_setprio(0); } while (0)
#define PG8_WAIT_V(n) asm volatile("s_waitcnt vmcnt(" #n ")" ::: "memory")
#define PG8_WAIT_L(n) asm volatile("s_waitcnt lgkmcnt(" #n ")" ::: "memory")
#define PG8_BAR __builtin_amdgcn_s_barrier()
#define PG8_SCHED __builtin_amdgcn_sched_barrier(0)
#define PG8_INIT(u) do { const int fq3 = pg8_lane() >> 4; f32x4 _bi[2][2]; E.init(_bi, (u), wc, fq3); \
        _Pragma("unroll") for (int a = 0; a < 2; ++a) _Pragma("unroll") for (int b = 0; b < 2; ++b) _Pragma("unroll") for (int m = 0; m < 4; ++m) _Pragma("unroll") for (int n = 0; n < 2; ++n) acc[a][b][m][n] = _bi[b][n]; } while (0)
    GUnit cur, nxt; int ui = 0;
    if (!S.next(0, cur)) return;
    f32x4 acc[2][2][4][2];
    PG8_INIT(cur);
    bf16x8 At[4][2], B0[2][2], B1[2][2];
    static_assert(!GATHER, "row gather was removed: the MoE operands live in per-expert slot regions");
    const char* cA = cur.A; const char* cB0 = cur.B0; const char* cB1 = cur.B1;
    if constexpr (SP2) {
        PG8_STAGE(PG8_SB(0, 0), cB0, voffB); PG8_STAGE(PG8_SB(0, 1), cB1, voffB); PG8_STAGE(PG8_SA(0, 0), cA, voffA); PG8_STAGE(PG8_SA(0, 1), cA + hoff, voffA);
        if (wr == 1) PG8_BAR;
        PG8_WAIT_V(2); PG8_BAR;
        PG8_STAGE(PG8_SB(1, 0), cB0 + kstep, voffB); PG8_STAGE(PG8_SA(1, 0), cA + kstep, voffA); PG8_STAGE(PG8_SB(1, 1), cB1 + kstep, voffB);
        PG8_WAIT_V(6); PG8_BAR;
    } else {
    PG8_STAGE(PG8_SB(0, 0), cB0, voffB); PG8_STAGE(PG8_SA(0, 0), cA, voffA); PG8_STAGE(PG8_SB(0, 1), cB1, voffB); PG8_STAGE(PG8_SA(0, 1), cA + hoff, voffA);
    if (wr == 1) PG8_BAR;
    PG8_WAIT_V(4); PG8_BAR;
    PG8_STAGE(PG8_SB(1, 0), cB0 + kstep, voffB); PG8_STAGE(PG8_SA(1, 0), cA + kstep, voffA); PG8_STAGE(PG8_SB(1, 1), cB1 + kstep, voffB);
    PG8_WAIT_V(6); PG8_BAR;
    }
    for (;;) {
        const bool has_next = S.next(ui + 1, nxt);
        const char* nA = has_next ? nxt.A : cA; const char* nB0 = has_next ? nxt.B0 : cB0; const char* nB1 = has_next ? nxt.B1 : cB1;
#pragma unroll 1
        for (int t = 0; t < nt; t += 2) {
            const bool last = (t == nt - 2);
            const char* a1 = cA + (size_t)(t + 1) * kstep;
            const char* a2 = last ? nA : cA + (size_t)(t + 2) * kstep;
            const char* b20 = last ? nB0 : cB0 + (size_t)(t + 2) * kstep; const char* b21 = last ? nB1 : cB1 + (size_t)(t + 2) * kstep;
            const char* a3 = a2 + kstep; const char* b30 = b20 + kstep; const char* b31 = b21 + kstep;
            if constexpr (SP2) {
            PG8_LDB(B0, 0, 0); PG8_LDB(B1, 0, 1); PG8_SCHED; PG8_LDA(At, 0, 0); PG8_STAGE(PG8_SA(1, 1), a1 + hoff, voffA);
            PG8_WAIT_V(8); PG8_WAIT_L(0); PG8_BAR; PG8_MMA(0, 0, At, B0); PG8_MMA(0, 1, At, B1); PG8_BAR; PG8_SCHED;
            PG8_LDA(At, 0, 1); PG8_STAGE(PG8_SB(0, 0), b20, voffB); PG8_STAGE(PG8_SB(0, 1), b21, voffB); PG8_STAGE(PG8_SA(0, 0), a2, voffA);
            PG8_WAIT_V(8); PG8_WAIT_L(0); PG8_BAR; PG8_MMA(1, 0, At, B0); PG8_MMA(1, 1, At, B1); PG8_BAR; PG8_SCHED;
            PG8_LDB(B0, 1, 0); PG8_LDB(B1, 1, 1); PG8_SCHED; PG8_LDA(At, 1, 0); PG8_STAGE(PG8_SA(0, 1), a2 + hoff, voffA);
            PG8_WAIT_V(8); PG8_WAIT_L(0); PG8_BAR; PG8_MMA(0, 0, At, B0); PG8_MMA(0, 1, At, B1); PG8_BAR; PG8_SCHED;
            PG8_LDA(At, 1, 1); PG8_STAGE(PG8_SB(1, 0), b30, voffB); PG8_STAGE(PG8_SB(1, 1), b31, voffB); PG8_STAGE(PG8_SA(1, 0), a3, voffA);
            PG8_WAIT_V(8); PG8_WAIT_L(0); PG8_BAR; PG8_MMA(1, 0, At, B0); PG8_MMA(1, 1, At, B1); PG8_BAR; PG8_SCHED;
            } else {
            PG8_LDB(B0, 0, 0); PG8_SCHED; PG8_LDA(At, 0, 0); PG8_STAGE(PG8_SA(1, 1), a1 + hoff, voffA);
            PG8_WAIT_L(8); PG8_BAR; PG8_WAIT_L(0); PG8_MMA(0, 0, At, B0); PG8_BAR; PG8_SCHED;
            PG8_LDB(B1, 0, 1); PG8_STAGE(PG8_SB(0, 0), b20, voffB);
            PG8_BAR; PG8_WAIT_L(0); PG8_MMA(0, 1, At, B1); PG8_BAR;
            PG8_LDA(At, 0, 1); PG8_STAGE(PG8_SA(0, 0), a2, voffA);
            PG8_BAR; PG8_WAIT_L(0); PG8_MMA(1, 0, At, B0); PG8_BAR; PG8_SCHED;
            PG8_STAGE(PG8_SB(0, 1), b21, voffB);
            PG8_WAIT_V(6); PG8_BAR; PG8_MMA(1, 1, At, B1); PG8_BAR;
            PG8_LDB(B0, 1, 0); PG8_SCHED; PG8_LDA(At, 1, 0); PG8_STAGE(PG8_SA(0, 1), a2 + hoff, voffA);
            PG8_WAIT_L(8); PG8_BAR; PG8_WAIT_L(0); PG8_MMA(0, 0, At, B0); PG8_BAR; PG8_SCHED;
            PG8_LDB(B1, 1, 1); PG8_STAGE(PG8_SB(1, 0), b30, voffB);
            PG8_BAR; PG8_WAIT_L(0); PG8_MMA(0, 1, At, B1); PG8_BAR;
            PG8_LDA(At, 1, 1); PG8_STAGE(PG8_SA(1, 0), a3, voffA);
            PG8_BAR; PG8_WAIT_L(0); PG8_MMA(1, 0, At, B0); PG8_BAR; PG8_SCHED;
            PG8_STAGE(PG8_SB(1, 1), b31, voffB);
            PG8_WAIT_V(6); PG8_BAR; PG8_MMA(1, 1, At, B1); PG8_BAR;
            }
        }
        if constexpr (ALIGN_EPI) { if (wr == 0) PG8_BAR; }
        { const int l2_ = pg8_lane(); const int fr2 = l2_ & 15, fq2 = l2_ >> 4;
          E(acc, cur, wr, wc, fr2, fq2); }
        if constexpr (Epi::PUB) {
            static_assert(ALIGN_EPI, "the publish barrier needs the two wave halves aligned");
            unsigned* const rf_ = E.ready_flag(cur);
            if (rf_ != nullptr) { PG8_WAIT_V(0); PG8_BAR; if (wid == 0 && pg8_lane() == 0) (void)xb_add(rf_, 1u); }
        }
        if (!has_next) break;
        PG8_INIT(nxt);
        cur = nxt; cA = nA; cB0 = nB0; cB1 = nB1; ++ui;
        if constexpr (ALIGN_EPI) { if (wr == 1) PG8_BAR; }
    }
    PG8_WAIT_V(0);
    if constexpr (!ALIGN_EPI) { if (wr == 0) PG8_BAR; }
    PG8_BAR;
#undef PG8_INIT
#undef PG8_SA
#undef PG8_SB
#undef PG8_STAGE
#undef PG8_LDA
#undef PG8_LDB
#undef PG8_MMA
#undef PG8_WAIT_V
#undef PG8_WAIT_L
#undef PG8_BAR
#undef PG8_SCHED
}
}
__device__ __forceinline__ void tr_item(const float* W, int ldn, int k0, int n0, int nvalid, bf16_t* WT, int ldk, int drow0, int dk0, LAS float* scr, int lane) {
    { float t[32]; const int nn = lane & 31;
#pragma unroll
      for (int i = 0; i < 32; ++i) { const int kk = 2 * i + (lane >> 5); t[i] = (nn < nvalid) ? W[(size_t)(k0 + kk) * ldn + n0 + nn] : 0.f; }
      __builtin_amdgcn_sched_barrier(0);
#pragma unroll
      for (int i = 0; i < 32; ++i) { const int kk = 2 * i + (lane >> 5); scr[kk * 33 + nn] = t[i]; } }
    LDS_WAIT(); asm volatile("" ::: "memory");
    const int c = lane & 7;
#pragma unroll
    for (int j = 0; j < 4; ++j) { const int n = (lane >> 3) + 8 * j; const LAS float* s = scr + (8 * c) * 33 + n;
        u32x4 o; o.x = cvtpk(s[0 * 33], s[1 * 33]); o.y = cvtpk(s[2 * 33], s[3 * 33]); o.z = cvtpk(s[4 * 33], s[5 * 33]); o.w = cvtpk(s[6 * 33], s[7 * 33]);
        if (n < nvalid) *(u32x4*)(WT + (size_t)(drow0 + n) * ldk + dk0 + k0 + 8 * c) = o; }
    LDS_WAIT(); asm volatile("" ::: "memory");
}
__device__ __forceinline__ void tr_item8(const float* W, int ldn, int k0, int n0, unsigned char* WT, int ldk, int drow0, float scale, LAS float* scr, int lane) {
#pragma unroll
    for (int h = 0; h < 2; ++h) { float t[32];
#pragma unroll
        for (int i = 0; i < 32; ++i) { const int kk = 2 * (32 * h + i) + (lane >> 5); t[i] = W[(size_t)(k0 + kk) * ldn + n0 + (lane & 31)]; }
        __builtin_amdgcn_sched_barrier(0);
#pragma unroll
        for (int i = 0; i < 32; ++i) { const int kk = 2 * (32 * h + i) + (lane >> 5); scr[kk * 33 + (lane & 31)] = t[i]; }
        __builtin_amdgcn_sched_barrier(0); }
    LDS_WAIT(); asm volatile("" ::: "memory");
#pragma unroll
    for (int j = 0; j < 4; ++j) { const int q = lane + 64 * j, n = q >> 3, c = q & 7; const LAS float* s = scr + (16 * c) * 33 + n;
        u32x4 o; o.x = pk4_fp8(s[0 * 33] * scale, s[1 * 33] * scale, s[2 * 33] * scale, s[3 * 33] * scale); o.y = pk4_fp8(s[4 * 33] * scale, s[5 * 33] * scale, s[6 * 33] * scale, s[7 * 33] * scale);
        o.z = pk4_fp8(s[8 * 33] * scale, s[9 * 33] * scale, s[10 * 33] * scale, s[11 * 33] * scale); o.w = pk4_fp8(s[12 * 33] * scale, s[13 * 33] * scale, s[14 * 33] * scale, s[15 * 33] * scale);
        *(u32x4*)(WT + (size_t)(drow0 + n) * ldk + k0 + 16 * c) = o; }
    LDS_WAIT(); asm volatile("" ::: "memory");
}
__device__ __forceinline__ void zero_rect(const Frame& F, bf16_t* base, int ldk, int row0, int nrows, int k0, int kw) {
    const int per = kw / 8; const int total = nrows * per;
    for (int i = F.bid * NTHREADS + F.tid; i < total; i += F.G * NTHREADS) { const int r = i / per, c = i % per; *(u32x4*)(base + (size_t)(row0 + r) * ldk + k0 + c * 8) = (u32x4){0u, 0u, 0u, 0u}; }
}

__device__ __forceinline__ void p0_prologue(const Frame& F) {
    {
        const float* pc_ = inp(I_C); const float* pcc_ = inp(I_CCTX); const float* pwm_ = inp(I_WMOD); const float* pbm_ = inp(I_BMOD);
        LAS float* sl = (LAS float*)F.lds;
        LAS float* red = (LAS float*)(F.lds + 5 * 1024 * 4);
        bool staged = false;
        for (int task = F.bid; task < 2 * 96; task += F.G) {
            const int layer = task / 96, jb = task % 96;
            if (!staged) {
                for (int i = F.tid; i < 5 * 1024; i += NTHREADS) { const int v = i >> 10, c = i & 1023; const float x = (v < 4) ? pc_[v * D + c] : pcc_[c]; sl[i] = silu_f(x); }
                __syncthreads(); staged = true;
            }
            const float* W = pwm_ + (size_t)layer * D * 6 * D + jb * 64 + F.lane;
            float a0 = 0.f, a1 = 0.f, a2 = 0.f, a3 = 0.f, a4 = 0.f;
            const int cb = F.wave * 128;
#pragma unroll 1
            for (int c0 = 0; c0 < 128; c0 += 32) { float wv[32];
#pragma unroll
                for (int c = 0; c < 32; ++c) wv[c] = W[(size_t)(cb + c0 + c) * 6 * D];
                __builtin_amdgcn_sched_barrier(0);
#pragma unroll
                for (int c = 0; c < 32; ++c) { const float w = wv[c]; const int cc = cb + c0 + c; a0 += sl[cc] * w; a1 += sl[1024 + cc] * w; a2 += sl[2048 + cc] * w; a3 += sl[3072 + cc] * w; a4 += sl[4096 + cc] * w; } }
            red[(F.wave * 5 + 0) * 64 + F.lane] = a0; red[(F.wave * 5 + 1) * 64 + F.lane] = a1; red[(F.wave * 5 + 2) * 64 + F.lane] = a2; red[(F.wave * 5 + 3) * 64 + F.lane] = a3; red[(F.wave * 5 + 4) * 64 + F.lane] = a4;
            __syncthreads();
            if (F.tid < 320) { const int v = F.tid >> 6, l = F.tid & 63; float s = 0.f;
#pragma unroll
                for (int w = 0; w < 8; ++w) s += red[(w * 5 + v) * 64 + l];
                const int j = jb * 64 + l;
                ((float*)(F.ws + WS_MOD))[(size_t)(layer * 5 + v) * 6 * D + j] = s + pbm_[layer * 6 * D + j]; }
            __syncthreads();
        }
        __syncthreads();
    }
    for (int i = F.bid * NTHREADS + F.tid; i < SEQ * 16; i += F.G * NTHREADS) {
        const int t = i >> 4, p = i & 15; const float pos = (p < 8) ? (float)(t >> 6) : (float)(t & 63);
        const float inv = powf(10000.0f, -(float)(p & 7) / 8.0f); const float ang = pos * inv; float s, c; sincosf(ang, &s, &c);
        float* T = (float*)(F.ws + WS_ROPEM) + (size_t)t * 32; T[p] = c; T[16 + p] = s;
    }
    for (int i = F.bid * NTHREADS + F.tid; i < SEQ * 32; i += F.G * NTHREADS) {
        const int t = i >> 5, p = i & 31; const float pos = (p < 16) ? (float)(t >> 6) : (float)(t & 63);
        const float inv = powf(10000.0f, -(float)(p & 15) / 16.0f); const float ang = pos * inv; float s, c; sincosf(ang, &s, &c);
        float* T = (float*)(F.ws + WS_ROPEG) + (size_t)t * 64; T[p] = c; T[32 + p] = s;
    }
    zero_rect(F, (bf16_t*)(F.ws + WS_WAIN), 512, ATTN_IN, ATTN_INP - ATTN_IN, 0, 512);
    zero_rect(F, (bf16_t*)(F.ws + WS_WUP), UPK, 0, 768, 256, 128);
    zero_rect(F, (bf16_t*)(F.ws + WS_WUP), UPK, 768, 1024, 0, 256);
    zero_rect(F, (bf16_t*)(F.ws + WS_WSIN), 512, 4608 + 32, SSM_INP - 4608 - 32, 0, 512);
    LAS float* scr = (LAS float*)(F.lds + F.wave * 16896);
    const int gw = F.bid * NWAVES + F.wave, NGW = F.G * NWAVES;
#define SEG(Wp, ldn, Kk, c0, nc, WTp, ldk, r0, kk0, nbatch, sstride, dstride) { const int nnb = ((nc) + 31) / 32, per = ((Kk) / 64) * nnb; const int ni = (nbatch) * per; \
        if (r < ni) { const int bb = r / per, q = r % per, kb = q / nnb, nb = q % nnb; const int nv = ((nc) - nb * 32) < 32 ? ((nc) - nb * 32) : 32; \
            tr_item((Wp) + (size_t)bb * (sstride), (ldn), kb * 64, (c0) + nb * 32, nv, (WTp) + (size_t)bb * (dstride), (ldk), (r0) + nb * 32, (kk0), scr, F.lane); continue; } r -= ni; }
#define SEG8(Wp, ldn, Kk, nc, WTp, ldk, nbatch, sstride, dstride) { const int nnb = (nc) / 32, per = ((Kk) / 128) * nnb; const int ni = (nbatch) * per; \
        if (r < ni) { const int bb = r / per, q = r % per, kb = q / nnb, nb = q % nnb; \
            tr_item8((Wp) + (size_t)bb * (sstride), (ldn), kb * 128, nb * 32, (WTp) + (size_t)bb * (dstride), (ldk), nb * 32, FP8_SW, scr, F.lane); continue; } r -= ni; }
    constexpr int N_ITEMS_TOTAL = 8 * 37 + 4 * 24 + 2 * 32 + 8 * 32 + 8 * (32 + 48 + 32 + 32 + 1) + 16 * 32;
    for (int it = gw; it < N_ITEMS_TOTAL; it += NGW) {
        int r = it;
        SEG8(inp(I_AWIN), ATTN_IN, 1024, ATTN_IN, (unsigned char*)(F.ws + WS_WAIN), 1024, 1, 0, 0)
        SEG(inp(I_WUQ), 768, 256, 0, 768, (bf16_t*)(F.ws + WS_WUP), UPK, 0, 0, 1, 0, 0)
        SEG(inp(I_WUKV), 1024, 128, 0, 1024, (bf16_t*)(F.ws + WS_WUP), UPK, 768, 256, 1, 0, 0)
        SEG8(inp(I_AWOUT), 1024, 1024, 1024, (unsigned char*)(F.ws + WS_WAOUT), 1024, 1, 0, 0)
        SEG8(inp(I_SWIN), SSM_IN, 1024, 1024, (unsigned char*)(F.ws + WS_WSIN), 1024, 1, 0, 0)
        SEG8(inp(I_SWIN) + 1024, SSM_IN, 1024, 1536, (unsigned char*)(F.ws + WS_WSIN) + (size_t)1024 * 1024, 1024, 1, 0, 0)
        SEG8(inp(I_SWIN) + 2576, SSM_IN, 1024, 1024, (unsigned char*)(F.ws + WS_WSIN) + (size_t)2560 * 1024, 1024, 1, 0, 0)
        SEG8(inp(I_SWIN) + 3600, SSM_IN, 1024, 1024, (unsigned char*)(F.ws + WS_WSIN) + (size_t)3584 * 1024, 1024, 1, 0, 0)
        SEG8(inp(I_SWIN) + 2560, SSM_IN, 1024, 32, (unsigned char*)(F.ws + WS_WSIN) + (size_t)4608 * 1024, 1024, 1, 0, 0)
        SEG8(inp(I_SWOUT), 1024, 2048, 1024, (unsigned char*)(F.ws + WS_WSOUT), 2048, 1, 0, 0)
    }
#undef SEG
#undef SEG8
}

__device__ __forceinline__ void norm_mod_store(const f32x4 (&v)[4], const float* g, const float* sh, const float* sc, bf16_t* orow, int lane) {
    float s = 0.f;
#pragma unroll
    for (int j = 0; j < 4; ++j) s += (v[j].x * v[j].x + v[j].y * v[j].y) + (v[j].z * v[j].z + v[j].w * v[j].w);
    f32x4 gg[4], ss[4], cc[4];
#pragma unroll
    for (int j = 0; j < 4; ++j) { const int c = 4 * lane + 256 * j; gg[j] = *(const f32x4*)(g + c); ss[j] = *(const f32x4*)(sh + c); cc[j] = *(const f32x4*)(sc + c); }
    __builtin_amdgcn_sched_barrier(0);
    const float inv = rsqrtf(wave_sum(s) * (1.0f / D) + EPS);
#pragma unroll
    for (int j = 0; j < 4; ++j) { const int c = 4 * lane + 256 * j;
        const float y0 = v[j].x * inv * gg[j].x * (1.f + cc[j].x) + ss[j].x, y1 = v[j].y * inv * gg[j].y * (1.f + cc[j].y) + ss[j].y, y2 = v[j].z * inv * gg[j].z * (1.f + cc[j].z) + ss[j].z, y3 = v[j].w * inv * gg[j].w * (1.f + cc[j].w) + ss[j].w;
        *(u32x2*)(orow + c) = (u32x2){cvtpk(y0, y1), cvtpk(y2, y3)}; }
}
__device__ __forceinline__ void norm_mod_store8(const f32x4 (&v)[4], const float* g, const float* sh, const float* sc, unsigned char* orow, int lane) {
    float s = 0.f;
#pragma unroll
    for (int j = 0; j < 4; ++j) s += (v[j].x * v[j].x + v[j].y * v[j].y) + (v[j].z * v[j].z + v[j].w * v[j].w);
    f32x4 gg[4], ss[4], cc[4];
#pragma unroll
    for (int j = 0; j < 4; ++j) { const int c = 4 * lane + 256 * j; gg[j] = *(const f32x4*)(g + c); ss[j] = *(const f32x4*)(sh + c); cc[j] = *(const f32x4*)(sc + c); }
    __builtin_amdgcn_sched_barrier(0);
    const float inv = rsqrtf(wave_sum(s) * (1.0f / D) + EPS);
#pragma unroll
    for (int j = 0; j < 4; ++j) { const int c = 4 * lane + 256 * j;
        const float y0 = v[j].x * inv * gg[j].x * (1.f + cc[j].x) + ss[j].x, y1 = v[j].y * inv * gg[j].y * (1.f + cc[j].y) + ss[j].y, y2 = v[j].z * inv * gg[j].z * (1.f + cc[j].z) + ss[j].z, y3 = v[j].w * inv * gg[j].w * (1.f + cc[j].w) + ss[j].w;
        *(unsigned*)(orow + c) = pk4_fp8(y0 * FP8_SH, y1 * FP8_SH, y2 * FP8_SH, y3 * FP8_SH); }
}
__device__ __forceinline__ void p1_norm_mod(const Frame& F) {
    const int gw = F.bid * NWAVES + F.wave, NGW = F.G * NWAVES; const float* ng_ = inp(I_NORMG);
    for (int r = gw; r < MR; r += NGW) {
        const float* xr = src_row(F, r); f32x4 v[4];
#pragma unroll
        for (int j = 0; j < 4; ++j) v[j] = *(const f32x4*)(xr + 4 * F.lane + 256 * j);
        norm_mod_store8(v, ng_, mod_vec(F, 0, r, 0), mod_vec(F, 0, r, 1), (unsigned char*)(F.ws + WS_H) + (size_t)r * D, F.lane);
    }
}
using pg8::GUnit;
__device__ __forceinline__ bool tile_of(int L, int nM, int nN, int& pm, int& pn) {
    const int nwg = nM * nN; if (L >= nwg) return false;
    int wgid = L; { const int q = nwg / 8, r = nwg % 8, xcd = wgid % 8, off = wgid / 8; wgid = (xcd < r ? xcd * (q + 1) : r * (q + 1) + (xcd - r) * q) + off; }
    const int nig = 8 * nN, gid = wgid / nig, fm = gid * 8, gsz = (nM - fm) < 8 ? (nM - fm) : 8;
    pm = fm + ((wgid % nig) % gsz); pn = (wgid % nig) / gsz; return true;
}
struct DenseOrder {
    const char* A; const char* B; int KB, nM, nN, G, c; bool lat_only;
    int pair0, pbase0, pbase1;
    int npair;
    unsigned ctx_mask;
    int nme = 0;
    __device__ __forceinline__ bool next(int i, GUnit& u) const {
        int pm, pn; const int L = i * G + c; int rt;
        if (ctx_mask != 0u && L >= 64 * nN) {
            const int nc = __builtin_popcount(ctx_mask); const int q = L - 64 * nN; if (q >= 4 * nc) return false;
            const int b = q / nc; int k = q % nc; unsigned m = ctx_mask; for (int j = 0; j < k; ++j) m &= m - 1u; pn = __builtin_ctz(m); rt = b * 17;
        } else {
            if (nme > 0) { const int ne = nme * nN; if (L < ne) (void)tile_of(L, nme, nN, pm, pn); else { if (!tile_of(L - ne, nM - nme, nN, pm, pn)) return false; pm += nme; } }
            else if (!tile_of(L, nM, nN, pm, pn)) return false;
            rt = lat_only ? (pm >> 4) * 17 + 1 + (pm & 15) : pm; }
        u.row0 = rt * 256; u.A = A + (size_t)u.row0 * KB; u.rows = nullptr; u.nrows = 0; u.e = pn;
        if (pn >= pair0 && pn < pair0 + npair) { const int j = pn - pair0; u.col0 = pbase0 + 128 * j; u.col1 = pbase1 + 128 * j; }
        else { u.col0 = 256 * pn; u.col1 = u.col0 + 128; }
        u.B0 = B + (size_t)u.col0 * KB; u.B1 = B + (size_t)u.col1 * KB; return true;
    }
};
#define EPI_LOOP_BEGIN \
    _Pragma("unroll") for (int ai = 0; ai < 2; ++ai) _Pragma("unroll") for (int m = 0; m < 4; ++m) { const int row = u.row0 + 128 * ai + 64 * wr + 16 * m + fr; \
    _Pragma("unroll") for (int bj = 0; bj < 2; ++bj) { const int col = (bj ? u.col1 : u.col0) + 32 * wc + 8 * fq; const f32x4 v0 = acc[ai][bj][m][0], v1 = acc[ai][bj][m][1];
#define EPI_LOOP_END } __builtin_amdgcn_sched_barrier(0); }

__device__ __forceinline__ u32x4 pack8(const f32x4& a, const f32x4& b) { return (u32x4){cvtpk(a.x, a.y), cvtpk(a.z, a.w), cvtpk(b.x, b.y), cvtpk(b.z, b.w)}; }
#define EPI_NO_PUB static constexpr bool PUB = false; __device__ __forceinline__ unsigned* ready_flag(const GUnit&) const { return nullptr; }
#define EPI_ZERO_INIT __device__ __forceinline__ void init(f32x4 (&bi)[2][2], const GUnit&, int, int) const { bi[0][0] = bi[0][1] = bi[1][0] = bi[1][1] = (f32x4){0.f, 0.f, 0.f, 0.f}; }
struct EpiBf16 {
    bf16_t* C; int ldc; unsigned* rdy; EPI_ZERO_INIT
    static constexpr bool PUB = true; __device__ __forceinline__ unsigned* ready_flag(const GUnit& u) const { return rdy + 64 * (u.row0 >> 8); }
    __device__ __forceinline__ void operator()(const f32x4 (&acc)[2][2][4][2], const GUnit& u, int wr, int wc, int fr, int fq) const {
        EPI_LOOP_BEGIN
            store_wt16(C + (size_t)row * ldc + col, pack8(v0 * (1.0f / (FP8_SW * FP8_SH)), v1 * (1.0f / (FP8_SW * FP8_SH))));
        EPI_LOOP_END
    }
};

struct EpiUp {
    bf16_t* Qm; unsigned char* Km; bf16_t* Vm; EPI_ZERO_INIT EPI_NO_PUB
    __device__ __forceinline__ void operator()(const f32x4 (&acc)[2][2][4][2], const GUnit& u, int wr, int wc, int fr, int fq) const {
        EPI_LOOP_BEGIN
            if (col < 768) { *(u32x4*)(Qm + (size_t)row * 768 + col) = pack8(v0 * C2M, v1 * C2M); }
            else { const int c2 = col - 768, hd = c2 >> 7, w = c2 & 127;
                if (w < 64) *(u32x2*)(Km + (size_t)row * 768 + hd * 96 + w) = (u32x2){pk4_fp8(v0.x, v0.y, v0.z, v0.w), pk4_fp8(v1.x, v1.y, v1.z, v1.w)};
                else *(u32x4*)(Vm + (size_t)row * 512 + hd * 64 + (w - 64)) = pack8(v0, v1); }
        EPI_LOOP_END
    }
};
template <bool LAYER0> struct EpiResid {
    Frame F; const bf16_t* R; bf16_t* O; int layer; unsigned* rdy; EPI_ZERO_INIT
    static constexpr float KA = 1.0f / (FP8_SW * FP8_SH);
    static constexpr bool PUB = LAYER0; __device__ __forceinline__ unsigned* ready_flag(const GUnit& u) const { return rdy + 64 * (u.row0 >> 8); }
    __device__ __forceinline__ void operator()(const f32x4 (&acc)[2][2][4][2], const GUnit& u, int wr, int wc, int fr, int fq) const {
        f32x4 g[2][2];
#pragma unroll
        for (int bj = 0; bj < 2; ++bj) { const float* gp = mod_vec(F, layer, u.row0, 2) + (bj ? u.col1 : u.col0) + 32 * wc + 8 * fq; g[bj][0] = *(const f32x4*)gp * KA; g[bj][1] = *(const f32x4*)(gp + 4) * KA; }
#pragma unroll
        for (int ai = 0; ai < 2; ++ai) {
            f32x4 r[4][2][2];
#pragma unroll
            for (int m = 0; m < 4; ++m) { const int row = u.row0 + 128 * ai + 64 * wr + 16 * m + fr;
#pragma unroll
                for (int bj = 0; bj < 2; ++bj) { const int col = (bj ? u.col1 : u.col0) + 32 * wc + 8 * fq;
                    if (LAYER0) { const float* rp = src_row(F, row) + col; r[m][bj][0] = *(const f32x4*)rp; r[m][bj][1] = *(const f32x4*)(rp + 4); }
                    else { const u32x4 rv = *(const u32x4*)(R + (size_t)row * D + col); r[m][bj][0] = (f32x4){bflo(rv.x), bfhi(rv.x), bflo(rv.y), bfhi(rv.y)}; r[m][bj][1] = (f32x4){bflo(rv.z), bfhi(rv.z), bflo(rv.w), bfhi(rv.w)}; } } }
            __builtin_amdgcn_sched_barrier(0);
#pragma unroll
            for (int m = 0; m < 4; ++m) { const int row = u.row0 + 128 * ai + 64 * wr + 16 * m + fr;
#pragma unroll
                for (int bj = 0; bj < 2; ++bj) { const int col = (bj ? u.col1 : u.col0) + 32 * wc + 8 * fq;
                    const u32x4 ov = pack8(r[m][bj][0] + g[bj][0] * acc[ai][bj][m][0], r[m][bj][1] + g[bj][1] * acc[ai][bj][m][1]);
                    if (LAYER0) store_wt16(O + (size_t)row * D + col, ov);
                    else *(u32x4*)(O + (size_t)row * D + col) = ov; } }
            __builtin_amdgcn_sched_barrier(0);
        }
    }
};
struct EpiSsmIn {
    bf16_t* Z; bf16_t* XR; bf16_t* V; float* DTR; EPI_ZERO_INIT EPI_NO_PUB
    static constexpr float KI = 1.0f / (FP8_SW * FP8_SH);
    __device__ __forceinline__ void operator()(const f32x4 (&acc)[2][2][4][2], const GUnit& u, int wr, int wc, int fr, int fq) const {
        const int pn = u.e;
        if (pn >= 10 && pn < 18) {
#pragma unroll
            for (int ai = 0; ai < 2; ++ai)
#pragma unroll
                for (int m = 0; m < 4; ++m) { const int row = u.row0 + 128 * ai + 64 * wr + 16 * m + fr; const int col = (u.col0 - 2560) + 32 * wc + 8 * fq;
                    f32x4 a0 = acc[ai][0][m][0], a1 = acc[ai][0][m][1]; const f32x4 b0 = acc[ai][1][m][0], b1 = acc[ai][1][m][1];
#pragma unroll
                    for (int j = 0; j < 4; ++j) { a0[j] = (a0[j] * KI) * sigmoid_f(b0[j] * KI); a1[j] = (a1[j] * KI) * sigmoid_f(b1[j] * KI); }
                    *(u32x4*)(V + (size_t)row * D + col) = pack8(a0, a1); }
        } else {
            EPI_LOOP_BEGIN
                if (col < 1024) *(u32x4*)(Z + (size_t)row * D + col) = pack8(v0 * KI, v1 * KI);
                else if (col < 2560) *(u32x4*)(XR + (size_t)row * XBC + (col - 1024)) = pack8(v0 * KI, v1 * KI);
                else if (col >= 4608 && col < 4624) { float* p = DTR + (size_t)row * 16 + (col - 4608); *(f32x4*)p = v0 * KI; *(f32x4*)(p + 4) = v1 * KI; }
            EPI_LOOP_END
        }
    }
};

__device__ __forceinline__ const LAS int* lds_vptr(const LAS int* p) { const LAS int* v; asm volatile("v_mov_b32 %0, %1" : "=v"(v) : "s"(p)); return v; }
struct MoeOrder {
    const LAS int* tab; const char* A; const char* B; int KB, nN, G, c; bool slots; size_t b_expert_bytes; int pair;
    __device__ __forceinline__ bool next(int i, GUnit& u) const {
        const LAS int* tab = lds_vptr(this->tab);
        const int nrb = __builtin_amdgcn_readfirstlane(tab[32]); const int nunits = nrb * nN; int L = i * G + c; if (L >= nunits) return false;
        { const int q = nunits / 8, r = nunits % 8, xcd = L % 8, off = L / 8; L = (xcd < r ? xcd * (q + 1) : r * (q + 1) + (xcd - r) * q) + off; }
        const int rb = L / nN, pn = L % nN;
        int e;
        { const int ln = pg8::pg8_lane(); const int tv = tab[ln & 31];
          e = __builtin_popcountll(__ballot(ln >= 1 && ln < 32 && tv <= rb)); }
        e = __builtin_amdgcn_readfirstlane(e);
        const int j = __builtin_amdgcn_readfirstlane(rb - tab[e]); const int cnt = __builtin_amdgcn_readfirstlane(tab[66 + e]);
        u.e = e; u.row0 = __builtin_amdgcn_readfirstlane(tab[33 + e]) + 256 * j;
        u.rows = nullptr; u.nrows = cnt - 256 * j; u.A = A + (slots ? ((size_t)e * MR + 256 * j) : (size_t)u.row0) * KB;
        const char* Be = B + (size_t)e * b_expert_bytes;
        if (pair) { u.col0 = 128 * pn; u.col1 = 1024 + 128 * pn; } else { u.col0 = 256 * pn; u.col1 = 256 * pn + 128; }
        u.B0 = Be + (size_t)u.col0 * KB; u.B1 = Be + (size_t)u.col1 * KB; return true;
    }
};
__device__ __forceinline__ void moe_table(const Frame& F, const unsigned* cnt, LAS int* tab) {
    if (F.tid < 64) {
        const int e = F.lane & 31; const int c = (int)__hip_atomic_load(cnt + 64 * e, __ATOMIC_RELAXED, __HIP_MEMORY_SCOPE_AGENT); const int nb = (c + 255) >> 8;
        int incl = nb;
#pragma unroll
        for (int o = 1; o < 32; o <<= 1) { const int t = __shfl_up(incl, o, 32); if (e >= o) incl += t; }
        if (F.lane < 32) { tab[e] = incl - nb; tab[33 + e] = (incl - nb) * 256; tab[66 + e] = c; if (e == 31) { tab[32] = incl; tab[65] = incl * 256; } }
    }
    __syncthreads();
}
struct EpiSwiglu {
    EPI_NO_PUB
    unsigned char* ACT; const float* bgu;
    __device__ __forceinline__ void init(f32x4 (&bi)[2][2], const GUnit& u, int wc, int fq) const {
        const float* bp = bgu + (size_t)u.e * 2048 + u.col0 + 32 * wc + 8 * fq;
        const float k = FP8_SW * FP8_SH;
        bi[0][0] = *(const f32x4*)bp * k; bi[0][1] = *(const f32x4*)(bp + 4) * k; bi[1][0] = *(const f32x4*)(bp + 1024) * k; bi[1][1] = *(const f32x4*)(bp + 1028) * k; }
    __device__ __forceinline__ void operator()(const f32x4 (&acc)[2][2][4][2], const GUnit& u, int wr, int wc, int fr, int fq) const {
        const int col = u.col0 + 32 * wc + 8 * fq;
#pragma unroll
        for (int ai = 0; ai < 2; ++ai)
#pragma unroll
            for (int m = 0; m < 4; ++m) { const int row = u.row0 + 128 * ai + 64 * wr + 16 * m + fr;
                constexpr float K1 = FP8_SW * FP8_SH, LIM = 7.0f * K1, KE = -1.702f * LOG2E / K1, KO = FP8_SA / (K1 * K1);
                f32x4 g0 = acc[ai][0][m][0], g1 = acc[ai][0][m][1]; const f32x4 p0 = acc[ai][1][m][0], p1 = acc[ai][1][m][1];
#pragma unroll
                for (int j = 0; j < 4; j += 2) {
                    const f32x2 ga = (f32x2){__builtin_amdgcn_fmed3f(g0[j], -3.0e38f, LIM), __builtin_amdgcn_fmed3f(g0[j + 1], -3.0e38f, LIM)}, gb = (f32x2){__builtin_amdgcn_fmed3f(g1[j], -3.0e38f, LIM), __builtin_amdgcn_fmed3f(g1[j + 1], -3.0e38f, LIM)};
                    const f32x2 ua = (f32x2){__builtin_amdgcn_fmed3f(p0[j], -LIM, LIM), __builtin_amdgcn_fmed3f(p0[j + 1], -LIM, LIM)}, ub = (f32x2){__builtin_amdgcn_fmed3f(p1[j], -LIM, LIM), __builtin_amdgcn_fmed3f(p1[j + 1], -LIM, LIM)};
                    const f32x2 ta = ga * KE, tb = gb * KE;
                    const f32x2 da = (f32x2){__builtin_amdgcn_exp2f(ta.x), __builtin_amdgcn_exp2f(ta.y)} + 1.0f, db = (f32x2){__builtin_amdgcn_exp2f(tb.x), __builtin_amdgcn_exp2f(tb.y)} + 1.0f;
                    const f32x2 sa = (f32x2){__builtin_amdgcn_rcpf(da.x), __builtin_amdgcn_rcpf(da.y)}, sb = (f32x2){__builtin_amdgcn_rcpf(db.x), __builtin_amdgcn_rcpf(db.y)};
                    const f32x2 ra = ((ua * KO + K1 * KO) * ga) * sa, rb = ((ub * KO + K1 * KO) * gb) * sb;
                    g0[j] = ra.x; g0[j + 1] = ra.y; g1[j] = rb.x; g1[j + 1] = rb.y; }
                *(u32x2*)(ACT + (size_t)row * D + col) = (u32x2){pk4_fp8_nc(g0[0], g0[1], g0[2], g0[3]), pk4_fp8_nc(g1[0], g1[1], g1[2], g1[3])};
                __builtin_amdgcn_sched_barrier(0); }
    }
};
struct EpiYs {
    EPI_NO_PUB
    unsigned char* YS; const float* bdn;
    __device__ __forceinline__ void init(f32x4 (&bi)[2][2], const GUnit& u, int wc, int fq) const {
        const float* bp = bdn + (size_t)u.e * D + 32 * wc + 8 * fq;
        const float k = FP8_SW * FP8_SA;
        bi[0][0] = *(const f32x4*)(bp + u.col0) * k; bi[0][1] = *(const f32x4*)(bp + u.col0 + 4) * k; bi[1][0] = *(const f32x4*)(bp + u.col1) * k; bi[1][1] = *(const f32x4*)(bp + u.col1 + 4) * k; }
    __device__ __forceinline__ void operator()(const f32x4 (&acc)[2][2][4][2], const GUnit& u, int wr, int wc, int fr, int fq) const {
        EPI_LOOP_BEGIN
            constexpr float ik = FP8_SY / (FP8_SW * FP8_SA);
            *(u32x2*)(YS + (size_t)row * D + col) = (u32x2){pk4_fp8(v0.x * ik, v0.y * ik, v0.z * ik, v0.w * ik), pk4_fp8(v1.x * ik, v1.y * ik, v1.z * ik, v1.w * ik)};
        EPI_LOOP_END
    }
};
__device__ __forceinline__ void p3_attn_post(const Frame& F, unsigned* rdy) {
    const int gw = F.bid * NWAVES + F.wave, NGW = F.G * NWAVES, lane = F.lane;
    const bf16_t* U0 = (const bf16_t*)(F.ws + WS_U0);
    bf16_t* CQ = (bf16_t*)(F.ws + WS_CQKV); unsigned char* Km = (unsigned char*)(F.ws + WS_KM); bf16_t* Qg = (bf16_t*)(F.ws + WS_QG); unsigned char* Kg = (unsigned char*)(F.ws + WS_KG);        bf16_t* Vg = (bf16_t*)(F.ws + WS_VG);
    const float* ropeM = (const float*)(F.ws + WS_ROPEM); const float* ropeG = (const float*)(F.ws + WS_ROPEG);
    const float* gcq = inp(I_GCQ); const float* gckv = inp(I_GCKV); const float* gq = inp(I_GQ); const float* gk = inp(I_GK);
    const int per = (MR + NGW - 1) / NGW;
    int a0 = gw * per, na = min(per, max(MR - a0, 0)), b0 = 0, nb = 0;
    int ea0 = F.bid * NWAVES * per, ea1 = min(ea0 + NWAVES * per, MR), lb0 = 0, lb1 = 0;
    if (F.G == 256) {
        const int x3 = min(max(F.bid - 168, 0), 32); nb = (F.bid >= 168 && F.bid < 200) ? 3 : 2;
        lb0 = 13056 + 16 * F.bid + 8 * x3; lb1 = lb0 + 8 * nb; b0 = lb0 + F.wave * nb;
        if (F.bid < 84) { na = 0; ea0 = ea1 = 0; }
        else { const int lw = gw - 672, lw0 = (F.bid - 84) * 8; a0 = lw * 9 + min(lw, 672); na = 9 + (lw < 672 ? 1 : 0); ea0 = lw0 * 9 + min(lw0, 672); ea1 = (lw0 + 8) * 9 + min(lw0 + 8, 672); }
    }
    const int l16 = lane & 15, part = lane & 7;
    const f32x4 g_cq = *(const f32x4*)(gcq + 4 * lane); const f32x2 g_ckv = *(const f32x2*)(gckv + 2 * lane);
    const f32x4 g_q0 = *(const f32x4*)(gq + part * 8), g_q1 = *(const f32x4*)(gq + part * 8 + 4), g_k0 = *(const f32x4*)(gk + part * 8), g_k1 = *(const f32x4*)(gk + part * 8 + 4);
    struct P3Row { u32x2 cq; unsigned ckv, kr; u32x4 qg, kg, vg; float mc, ms; f32x4 gc, gs; };
    auto load_row = [&](int r, P3Row& R) {
        const bf16_t* ur = U0 + (size_t)r * ATTN_INP; const int tp = r % TPB; const int t = tp >= CTXL ? tp - CTXL : 0;
        R.cq = *(const u32x2*)(ur + 4 * lane); R.ckv = *(const unsigned*)(ur + 256 + 2 * lane); R.kr = *(const unsigned*)(ur + 384 + 2 * l16);
        R.qg = *(const u32x4*)(ur + 416 + 8 * lane); R.kg = *(const u32x4*)(ur + 928 + l16 * 8); R.vg = *(const u32x4*)(ur + 1056 + l16 * 8);
        R.mc = ropeM[(size_t)t * 32 + l16]; R.ms = ropeM[(size_t)t * 32 + 16 + l16];
        const float* T = ropeG + (size_t)t * 64 + part * 4; R.gc = *(const f32x4*)T; R.gs = *(const f32x4*)(T + 32);
    };
    auto finish_row = [&](int r, const P3Row& R) {
        const bool lat = (r % TPB) >= CTXL;
        { const f32x4 v = (f32x4){bflo(R.cq.x), bfhi(R.cq.x), bflo(R.cq.y), bfhi(R.cq.y)}; const float s = wave_sum((v.x * v.x + v.y * v.y) + (v.z * v.z + v.w * v.w)); const float inv = rsqrtf(s * (1.f / 256.f) + EPS);
          *(u32x2*)(CQ + (size_t)r * UPK + 4 * lane) = (u32x2){cvtpk(v.x * inv * g_cq.x, v.y * inv * g_cq.y), cvtpk(v.z * inv * g_cq.z, v.w * inv * g_cq.w)}; }
        { const f32x2 v = (f32x2){bflo(R.ckv), bfhi(R.ckv)}; const float s = wave_sum(v.x * v.x + v.y * v.y); const float inv = rsqrtf(s * (1.f / 128.f) + EPS);
          *(unsigned*)(CQ + (size_t)r * UPK + 256 + 2 * lane) = cvtpk(v.x * inv * g_ckv.x, v.y * inv * g_ckv.y); }
        { const f32x2 v = (f32x2){bflo(R.kr), bfhi(R.kr)}; float e = v.x, o = v.y;
            if (lat) { e = v.x * R.mc - v.y * R.ms; o = v.x * R.ms + v.y * R.mc; }
            const unsigned short w = (unsigned short)(pk4_fp8(e, o, 0.f, 0.f) & 0xffffu);
            if (lane < 16) {
#pragma unroll
                for (int hd = 0; hd < 8; ++hd) *(unsigned short*)(Km + (size_t)r * 768 + hd * 96 + 64 + 2 * lane) = w; } }
        { const u32x4 w = R.qg; f32x4 a = (f32x4){bflo(w.x), bfhi(w.x), bflo(w.y), bfhi(w.y)}, b = (f32x4){bflo(w.z), bfhi(w.z), bflo(w.w), bfhi(w.w)};
          float s = (a.x * a.x + a.y * a.y) + (a.z * a.z + a.w * a.w) + (b.x * b.x + b.y * b.y) + (b.z * b.z + b.w * b.w);
          s += __shfl_xor(s, 1); s += __shfl_xor(s, 2); s += __shfl_xor(s, 4); const float inv = rsqrtf(s * (1.f / 64.f) + EPS);
          a = a * inv * g_q0; b = b * inv * g_q1;
          if (lat) { const f32x4 cs = R.gc, sn = R.gs;
              const f32x4 a2 = (f32x4){a.x * cs.x - a.y * sn.x, a.x * sn.x + a.y * cs.x, a.z * cs.y - a.w * sn.y, a.z * sn.y + a.w * cs.y};
              const f32x4 b2 = (f32x4){b.x * cs.z - b.y * sn.z, b.x * sn.z + b.y * cs.z, b.z * cs.w - b.w * sn.w, b.z * sn.w + b.w * cs.w}; a = a2; b = b2; }
          *(u32x4*)(Qg + (size_t)r * 512 + 8 * lane) = pack8(a * C2G, b * C2G); }
        { const u32x4 w = R.kg; f32x4 a = (f32x4){bflo(w.x), bfhi(w.x), bflo(w.y), bfhi(w.y)}, b = (f32x4){bflo(w.z), bfhi(w.z), bflo(w.w), bfhi(w.w)};
          float s = (a.x * a.x + a.y * a.y) + (a.z * a.z + a.w * a.w) + (b.x * b.x + b.y * b.y) + (b.z * b.z + b.w * b.w);
          s += __shfl_xor(s, 1); s += __shfl_xor(s, 2); s += __shfl_xor(s, 4); const float inv = rsqrtf(s * (1.f / 64.f) + EPS);
          a = a * inv * g_k0; b = b * inv * g_k1;
          if (lat) { const f32x4 cs = R.gc, sn = R.gs;
              const f32x4 a2 = (f32x4){a.x * cs.x - a.y * sn.x, a.x * sn.x + a.y * cs.x, a.z * cs.y - a.w * sn.y, a.z * sn.y + a.w * cs.y};
              const f32x4 b2 = (f32x4){b.x * cs.z - b.y * sn.z, b.x * sn.z + b.y * cs.z, b.z * cs.w - b.w * sn.w, b.z * sn.w + b.w * cs.w}; a = a2; b = b2; }
          if (lane < 16) { *(u32x2*)(Kg + (size_t)r * 128 + l16 * 8) = (u32x2){pk4_fp8(a.x, a.y, a.z, a.w), pk4_fp8(b.x, b.y, b.z, b.w)}; *(u32x4*)(Vg + (size_t)r * 128 + l16 * 8) = R.vg; } }
    };
    if (F.tid == 0) wait_rows_ready(rdy, ea0, ea1, 5u);
    __syncthreads();
#pragma unroll 1
    for (int seg = 0; seg < 2; ++seg) {
        const int n = seg ? nb : na, base = seg ? b0 : a0; if (n == 0) continue;
        if (seg) { __syncthreads(); if (F.tid == 0) wait_rows_ready(rdy, lb0, lb1, 5u); __syncthreads(); }
        P3Row cur, nx; load_row(base, cur);
#pragma unroll 1
        for (int it = 0; it < n; ++it) {
            nx = cur; if (it + 1 < n) load_row(base + it + 1, nx);
            __builtin_amdgcn_sched_barrier(0);
            finish_row(base + it, cur); cur = nx;
        }
    }
}

template <int DK> struct AttnCfg { static constexpr int KSTR = DK * 2 + 16, KBYTES = 64 * KSTR, VOFF = KBYTES, BUF = KBYTES + 8192, NKP = 64 * (DK / 8); };
__device__ __forceinline__ s16x4 tr_read(const LAS char* p) { typedef short v4i16_t __attribute__((ext_vector_type(4))); return __builtin_bit_cast(s16x4, __builtin_amdgcn_ds_read_tr16_b64_v4i16((LAS v4i16_t*)p)); }

template <int DK>
__device__ __forceinline__ void attn_unit(const bf16_t* Q, int qpitch, const unsigned char* Kp  , int kpitch, const bf16_t* Vp, int vpitch, unsigned char* O, int opitch, int NT, LAS char* lds, int tid, const float* rope  ) {
    typedef AttnCfg<DK> C; constexpr int ND = DK / 16;
    const int lane = tid & 63, wid = __builtin_amdgcn_readfirstlane(tid >> 6), r32 = lane & 31, hi = lane >> 5;
    const int kr0 = tid / (DK / 8), kc0 = tid % (DK / 8); const int p1 = tid + 512; const bool has1 = p1 < C::NKP; const int kr1 = p1 / (DK / 8), kc1 = p1 % (DK / 8);
    const int vr = tid >> 3, vc = tid & 7;
    const unsigned char* kg0 = Kp + (size_t)kr0 * kpitch + kc0 * 8; const unsigned char* kg1 = Kp + (size_t)kr1 * kpitch + kc1 * 8; const bf16_t* vg = Vp + (size_t)vr * vpitch + vc * 8;
    const int kl0 = kr0 * C::KSTR + kc0 * 16, kl1 = kr1 * C::KSTR + kc1 * 16, vl = C::VOFF + (vc >> 2) * 4096 + vr * 64 + (vc & 3) * 16;
    u32x4 sk0, sk1 = (u32x4){0u, 0u, 0u, 0u}, sv;
#define ATT_K16(w_) ([](u32x2 q_) { const f32x2 a_ = __builtin_amdgcn_cvt_pk_f32_fp8((int)q_.x, false), b_ = __builtin_amdgcn_cvt_pk_f32_fp8((int)q_.x, true), c_ = __builtin_amdgcn_cvt_pk_f32_fp8((int)q_.y, false), d_ = __builtin_amdgcn_cvt_pk_f32_fp8((int)q_.y, true); \
        return (u32x4){cvtpk(a_.x, a_.y), cvtpk(b_.x, b_.y), cvtpk(c_.x, c_.y), cvtpk(d_.x, d_.y)}; }(w_))
#define ATT_GLOAD(t_) do { const size_t ko_ = (size_t)(t_) * 64 * kpitch, vo_ = (size_t)(t_) * 64 * vpitch; sk0 = ATT_K16(*(const u32x2*)(kg0 + ko_)); if (has1) sk1 = ATT_K16(*(const u32x2*)(kg1 + ko_)); sv = *(const u32x4*)(vg + vo_); } while (0)
#define ATT_LSTORE(b_) do { LAS char* nb_ = lds + (b_) * C::BUF; *(LAS u32x4*)(nb_ + kl0) = sk0; if (has1) *(LAS u32x4*)(nb_ + kl1) = sk1; *(LAS u32x4*)(nb_ + vl) = sv; } while (0)
    ATT_GLOAD(0);
    bf16x8 qf[ND];
#pragma unroll
    for (int d0 = 0; d0 < ND; ++d0) qf[d0] = *(const bf16x8*)(Q + (size_t)(wid * 32 + r32) * qpitch + d0 * 16 + hi * 8);
    if (DK == 96 && rope != nullptr) {
#pragma unroll
        for (int f = 0; f < 2; ++f) { const float* T = rope + (size_t)(wid * 32 + r32) * 32 + 8 * f + 4 * hi; const f32x4 cs = *(const f32x4*)T, sn = *(const f32x4*)(T + 16);
            const u32x4 w = __builtin_bit_cast(u32x4, qf[ND - 2 + f]);
            const float e0 = bflo(w.x), o0 = bfhi(w.x), e1 = bflo(w.y), o1 = bfhi(w.y), e2 = bflo(w.z), o2 = bfhi(w.z), e3 = bflo(w.w), o3 = bfhi(w.w);
            const u32x4 rw = (u32x4){cvtpk(e0 * cs.x - o0 * sn.x, e0 * sn.x + o0 * cs.x), cvtpk(e1 * cs.y - o1 * sn.y, e1 * sn.y + o1 * cs.y), cvtpk(e2 * cs.z - o2 * sn.z, e2 * sn.z + o2 * cs.z), cvtpk(e3 * cs.w - o3 * sn.w, e3 * sn.w + o3 * cs.w)};
            qf[ND - 2 + f] = __builtin_bit_cast(bf16x8, rw); }
    }
    ATT_LSTORE(0);
    if (NT > 1) { ATT_GLOAD(1); ATT_LSTORE(1); }
    __syncthreads();
    const int kfo = r32 * C::KSTR + hi * 16;
    const int vfo = C::VOFF + (4 * hi + ((lane & 15) >> 2)) * 64 + ((lane >> 4) & 1) * 32 + (lane & 3) * 8;
#define ATT_QK(s0_, s1_, buf_) do { \
        _Pragma("unroll") for (int d0 = 0; d0 < ND; ++d0) { \
            const bf16x8 ka_ = *(const LAS bf16x8*)((buf_) + kfo + d0 * 32), kb_ = *(const LAS bf16x8*)((buf_) + kfo + 32 * C::KSTR + d0 * 32); \
            s0_ = __builtin_amdgcn_mfma_f32_32x32x16_bf16(ka_, qf[d0], d0 == 0 ? negm : s0_, 0, 0, 0); \
            s1_ = __builtin_amdgcn_mfma_f32_32x32x16_bf16(kb_, qf[d0], d0 == 0 ? negm : s1_, 0, 0, 0); } } while (0)
    f32x16 o0 = {}, o1 = {}, negm = {};
    float mref = 0.f, lsum = 0.f;
    f32x16 s0, s1, n0, n1;
    ATT_QK(s0, s1, lds);
    int bcur = 0, bnxt = 1, bfree = 2;
#define ATT_STEP(c0_, c1_, x0_, x1_, t_) do { \
        const LAS char* buf = lds + bcur * C::BUF; \
        const bool more2 = ((t_) + 2 < NT); \
        if (more2) ATT_GLOAD((t_) + 2); \
        float mx = fmaxf(c0_[0], c1_[0]); \
        _Pragma("unroll") for (int r = 1; r < 16; ++r) mx = fmaxf(fmaxf(mx, c0_[r]), c1_[r]); \
        mx = fmaxf(mx, __shfl_xor(mx, 32)); \
        if (__any(mx > 6.0f) || (t_) == 0) {                                    \
            const float dl = ((t_) == 0) ? mx : fmaxf(mx, 0.f); const float alpha = __builtin_amdgcn_exp2f(-dl); mref += dl; lsum *= alpha; \
            _Pragma("unroll") for (int r = 0; r < 16; ++r) { o0[r] *= alpha; o1[r] *= alpha; c0_[r] -= dl; c1_[r] -= dl; negm[r] = -mref; } \
        } \
          \
        ATT_QK(x0_, x1_, lds + bnxt * C::BUF); \
        float ps = 0.f; \
        _Pragma("unroll") for (int r = 0; r < 16; ++r) { c0_[r] = __builtin_amdgcn_exp2f(c0_[r]); c1_[r] = __builtin_amdgcn_exp2f(c1_[r]); ps += c0_[r] + c1_[r]; } \
        lsum += ps; \
        _Pragma("unroll") for (int kb = 0; kb < 2; ++kb) _Pragma("unroll") for (int ks = 0; ks < 2; ++ks) { \
                const f32x16& s = kb ? c1_ : c0_; \
                u32x4 pw = (u32x4){cvtpk(s[8 * ks + 0], s[8 * ks + 1]), cvtpk(s[8 * ks + 2], s[8 * ks + 3]), cvtpk(s[8 * ks + 4], s[8 * ks + 5]), cvtpk(s[8 * ks + 6], s[8 * ks + 7])}; \
                const bf16x8 pf = __builtin_bit_cast(bf16x8, pw); \
                const LAS char* vb = buf + vfo + (32 * kb + 16 * ks) * 64; \
                const s16x4 a0 = tr_read(vb), a1 = tr_read(vb + 512), b0 = tr_read(vb + 4096), b1 = tr_read(vb + 4096 + 512); \
                const bf16x8 va = (bf16x8){a0[0], a0[1], a0[2], a0[3], a1[0], a1[1], a1[2], a1[3]}, vb8 = (bf16x8){b0[0], b0[1], b0[2], b0[3], b1[0], b1[1], b1[2], b1[3]}; \
                o0 = __builtin_amdgcn_mfma_f32_32x32x16_bf16(va, pf, o0, 0, 0, 0); \
                o1 = __builtin_amdgcn_mfma_f32_32x32x16_bf16(vb8, pf, o1, 0, 0, 0); } \
        if (more2) ATT_LSTORE(bfree); \
        __syncthreads(); \
        { const int tb = bcur; bcur = bnxt; bnxt = bfree; bfree = tb; } } while (0)
    for (int t = 0; t < NT; t += 2) {
        ATT_STEP(s0, s1, n0, n1, t);
        if (t + 1 < NT) ATT_STEP(n0, n1, s0, s1, t + 1);
    }
#undef ATT_STEP
#undef ATT_GLOAD
#undef ATT_LSTORE
#undef ATT_QK
    lsum += __shfl_xor(lsum, 32);
    const float inv = 1.0f / lsum;
    unsigned char* orow = O + (size_t)(wid * 32 + r32) * opitch;
#pragma unroll
    for (int i = 0; i < 4; ++i) {
        *(unsigned*)(orow + 8 * i + 4 * hi) = pk4_fp8(o0[4 * i] * (inv * FP8_SH), o0[4 * i + 1] * (inv * FP8_SH), o0[4 * i + 2] * (inv * FP8_SH), o0[4 * i + 3] * (inv * FP8_SH));
        *(unsigned*)(orow + 32 + 8 * i + 4 * hi) = pk4_fp8(o1[4 * i] * (inv * FP8_SH), o1[4 * i + 1] * (inv * FP8_SH), o1[4 * i + 2] * (inv * FP8_SH), o1[4 * i + 3] * (inv * FP8_SH));
    }
}

struct BgCvt { const float* wgu; const float* wdn; unsigned char* tgu; unsigned char* tdn; LAS unsigned* scr; int item, end, step; int pitem, pstep; };
constexpr int BG_GU = 64 * 32 * 8, BG_DN = 64 * 16 * 8, BG_TOTAL = BG_GU + BG_DN;
constexpr int BG_LDS_OFF = 66 * 1024;
__device__ __forceinline__ void bg_addr(const BgCvt& g, int it, const float*& src, int& ldn, unsigned char*& dst) {
    if (it < BG_GU) { const int e = it >> 8, q = it & 255, nb = q >> 3, kq = q & 7; ldn = 2048;
        src = g.wgu + (size_t)e * 1024 * 2048 + (size_t)(kq * 128) * 2048 + nb * 64; dst = g.tgu + (size_t)e * 2048 * 1024 + (size_t)(nb * 64) * 1024 + kq * 128; }
    else { const int s2 = it - BG_GU; const int e = s2 >> 7, q = s2 & 127, nb = q >> 3, kq = q & 7; ldn = 1024;
        src = g.wdn + (size_t)e * 1024 * 1024 + (size_t)(kq * 128) * 1024 + nb * 64; dst = g.tdn + (size_t)e * 1024 * 1024 + (size_t)(nb * 64) * 1024 + kq * 128; }
}
#define BG_LOAD(g_, lane_, v_) do { const int it_ = (g_).item < (g_).end ? (g_).item : (g_).end - 1; const int st_ = (g_).step < 16 ? (g_).step : 15; \
        const float* s_; int l_; unsigned char* d_; bg_addr((g_), it_, s_, l_, d_); s_ += (size_t)(st_ * 8) * l_; \
        unsigned lo_ = (unsigned)(lane_) * 4u; asm volatile("" : "+v"(lo_));        \
        _Pragma("unroll") for (int i_ = 0; i_ < 8; ++i_) v_[i_] = *(const float*)((const char*)(s_ + (size_t)i_ * l_) + lo_); } while (0)
#define BG_PACK(g_, lane_, w_) do { if ((g_).pitem >= 0 && (g_).pstep < 16) { \
            (g_).scr[(lane_) * 33 + 2 * (g_).pstep] = pk4_fp8(w_[0] * FP8_SW, w_[1] * FP8_SW, w_[2] * FP8_SW, w_[3] * FP8_SW); \
            (g_).scr[(lane_) * 33 + 2 * (g_).pstep + 1] = pk4_fp8(w_[4] * FP8_SW, w_[5] * FP8_SW, w_[6] * FP8_SW, w_[7] * FP8_SW); } } while (0)
#define BG_FLUSH(g_, lane_) do { \
        if ((g_).pitem >= 0 && (g_).pstep == 16) { const float* s_; int l_; unsigned char* d_; bg_addr((g_), (g_).pitem, s_, l_, d_); LDS_WAIT(); \
            _Pragma("unroll") for (int j_ = 0; j_ < 8; ++j_) { const int n_ = 8 * j_ + ((lane_) >> 3), c_ = (lane_) & 7; const LAS unsigned* p_ = (g_).scr + n_ * 33 + 4 * c_; \
                *(u32x4*)(d_ + (size_t)n_ * 1024 + 16 * c_) = (u32x4){p_[0], p_[1], p_[2], p_[3]}; } \
            LDS_WAIT(); } \
        if ((g_).item < (g_).end) { (g_).pitem = (g_).item; (g_).pstep = (g_).step; if (++(g_).step > 16) { (g_).step = 0; ++(g_).item; } } else (g_).pitem = -1; } while (0)
#ifndef MK_ATT_STAGGER
#define MK_ATT_STAGGER 0
#endif
template <int DK>
__device__ __forceinline__ bool attn_unit_fast(const bf16_t* Q, int qpitch, const unsigned char* Kp  , int kpitch, const bf16_t* Vp, int vpitch, unsigned char* O, int opitch, int NT, LAS char* lds, int tid, const float* rope  , BgCvt& bg, float (&bgA)[8], float (&bgB)[8]) {
    typedef AttnCfg<DK> C;
    constexpr int K8W = (DK == 96 ? 128 : 64), KSTR8 = K8W + 16, VOFF8 = 64 * KSTR8, BUF8 = VOFF8 + 8192, NC = K8W / 64;
    typedef int v8i_t __attribute__((ext_vector_type(8)));
    const int lane = tid & 63, wid = __builtin_amdgcn_readfirstlane(tid >> 6), r32 = lane & 31, hi = lane >> 5;
    constexpr int P16 = DK / 16; const bool kact = tid < 64 * P16; const int kr0 = tid / P16, kc0 = tid % P16;
    const int vr = tid >> 3, vc = tid & 7;
    const int ko0 = kr0 * kpitch + kc0 * 16, vo0 = vr * vpitch + vc * 8;
    const int kl0 = kr0 * KSTR8 + kc0 * 16, vl = VOFF8 + (vc >> 2) * 4096 + vr * 64 + (vc & 3) * 16;
    u32x4 sk0 = (u32x4){0u, 0u, 0u, 0u}, sv;
#define ATT_GLOAD(t_) do { const unsigned char* kb_ = Kp + (size_t)(t_) * 64 * kpitch; const bf16_t* vb_ = Vp + (size_t)(t_) * 64 * vpitch; int a_ = ko0, c_ = vo0; asm volatile("" : "+v"(a_), "+v"(c_)); \
        if (kact) sk0 = *(const u32x4*)(kb_ + a_); sv = *(const u32x4*)(vb_ + c_); } while (0)
#define ATT_LSTORE(b_) do { LAS char* nb_ = lds + (b_) * BUF8; if (kact) *(LAS u32x4*)(nb_ + kl0) = sk0; *(LAS u32x4*)(nb_ + vl) = sv; } while (0)
    ATT_GLOAD(0);
    if (DK == 96 && tid < 384) { const int bz_ = tid >> 7, rz_ = (tid & 127) >> 1, hz_ = tid & 1; *(LAS u32x4*)(lds + bz_ * BUF8 + rz_ * KSTR8 + 96 + 16 * hz_) = (u32x4){0u, 0u, 0u, 0u}; }
    v8i_t q8[NC];
#pragma unroll
    for (int c = 0; c < NC; ++c) {
        const bool valid = (64 * c + 32 * hi) < DK;
        u32x4 w4[4];
#pragma unroll
        for (int i = 0; i < 4; ++i) w4[i] = valid ? *(const u32x4*)(Q + (size_t)(wid * 32 + r32) * qpitch + 64 * c + 32 * hi + 8 * i) : (u32x4){0u, 0u, 0u, 0u};
        float f[32];
#pragma unroll
        for (int i = 0; i < 4; ++i) { f[8 * i] = bflo(w4[i].x); f[8 * i + 1] = bfhi(w4[i].x); f[8 * i + 2] = bflo(w4[i].y); f[8 * i + 3] = bfhi(w4[i].y); f[8 * i + 4] = bflo(w4[i].z); f[8 * i + 5] = bfhi(w4[i].z); f[8 * i + 6] = bflo(w4[i].w); f[8 * i + 7] = bfhi(w4[i].w); }
        if (DK == 96 && c == 1 && rope != nullptr && hi == 0) {
            const float* T = rope + (size_t)(wid * 32 + r32) * 32;
#pragma unroll
            for (int p4 = 0; p4 < 4; ++p4) { const f32x4 cs = *(const f32x4*)(T + 4 * p4), sn = *(const f32x4*)(T + 16 + 4 * p4);
#pragma unroll
                for (int i = 0; i < 4; ++i) { const int pp = 4 * p4 + i; const float e = f[2 * pp], o = f[2 * pp + 1]; f[2 * pp] = e * cs[i] - o * sn[i]; f[2 * pp + 1] = e * sn[i] + o * cs[i]; } }
        }
#pragma unroll
        for (int i = 0; i < 8; ++i) q8[c][i] = (int)pk4_fp8(f[4 * i], f[4 * i + 1], f[4 * i + 2], f[4 * i + 3]);
    }
    ATT_LSTORE(0);
    if (NT > 1) { ATT_GLOAD(1); ATT_LSTORE(1); }
    __syncthreads();
    const int kfo = r32 * KSTR8 + hi * 32;
    const int vfo = VOFF8 + (4 * hi + ((lane & 15) >> 2)) * 64 + ((lane >> 4) & 1) * 32 + (lane & 3) * 8;
#define ATT_QK(s0_, s1_, buf_) do { \
        _Pragma("unroll") for (int c_ = 0; c_ < NC; ++c_) { \
            const u32x4 a0_ = *(const LAS u32x4*)((buf_) + kfo + 64 * c_), a1_ = *(const LAS u32x4*)((buf_) + kfo + 64 * c_ + 16); \
            const u32x4 b0_ = *(const LAS u32x4*)((buf_) + kfo + 32 * KSTR8 + 64 * c_), b1_ = *(const LAS u32x4*)((buf_) + kfo + 32 * KSTR8 + 64 * c_ + 16); \
            s0_ = __builtin_amdgcn_mfma_scale_f32_32x32x64_f8f6f4((v8i_t){(int)a0_.x, (int)a0_.y, (int)a0_.z, (int)a0_.w, (int)a1_.x, (int)a1_.y, (int)a1_.z, (int)a1_.w}, q8[c_], c_ == 0 ? zero16 : s0_, 0, 0, 0, 0, 0, 0); \
            s1_ = __builtin_amdgcn_mfma_scale_f32_32x32x64_f8f6f4((v8i_t){(int)b0_.x, (int)b0_.y, (int)b0_.z, (int)b0_.w, (int)b1_.x, (int)b1_.y, (int)b1_.z, (int)b1_.w}, q8[c_], c_ == 0 ? zero16 : s1_, 0, 0, 0, 0, 0, 0); } } while (0)
    f32x16 o0 = {}, o1 = {}, osum = {}; const f32x16 zero16 = {};
    const bf16x8 ones = (bf16x8){0x3F80, 0x3F80, 0x3F80, 0x3F80, 0x3F80, 0x3F80, 0x3F80, 0x3F80};
    f32x16 s0, s1, n0, n1;
    ATT_QK(s0, s1, lds);
    int bcur = 0, bnxt = 1, bfree = 2;
#define ATT_STEP(c0_, c1_, x0_, x1_, t_, bl_, bs_) do { \
        const LAS char* buf = lds + bcur * BUF8; \
        const bool more2 = ((t_) + 2 < NT); \
        if (more2) ATT_GLOAD((t_) + 2); \
        BG_LOAD(bg, lane, bl_); \
          \
        ATT_QK(x0_, x1_, lds + bnxt * BUF8); \
        _Pragma("unroll") for (int r = 0; r < 16; ++r) { c0_[r] = __builtin_amdgcn_exp2f(c0_[r]); c1_[r] = __builtin_amdgcn_exp2f(c1_[r]); } \
        _Pragma("unroll") for (int kb = 0; kb < 2; ++kb) _Pragma("unroll") for (int ks = 0; ks < 2; ++ks) { \
                const f32x16& s = kb ? c1_ : c0_; \
                u32x4 pw = (u32x4){cvtpk(s[8 * ks + 0], s[8 * ks + 1]), cvtpk(s[8 * ks + 2], s[8 * ks + 3]), cvtpk(s[8 * ks + 4], s[8 * ks + 5]), cvtpk(s[8 * ks + 6], s[8 * ks + 7])}; \
                const bf16x8 pf = __builtin_bit_cast(bf16x8, pw); \
                const LAS char* vb = buf + vfo + (32 * kb + 16 * ks) * 64; \
                const s16x4 a0 = tr_read(vb), a1 = tr_read(vb + 512), b0 = tr_read(vb + 4096), b1 = tr_read(vb + 4096 + 512); \
                const bf16x8 va = (bf16x8){a0[0], a0[1], a0[2], a0[3], a1[0], a1[1], a1[2], a1[3]}, vb8 = (bf16x8){b0[0], b0[1], b0[2], b0[3], b1[0], b1[1], b1[2], b1[3]}; \
                o0 = __builtin_amdgcn_mfma_f32_32x32x16_bf16(va, pf, o0, 0, 0, 0); \
                o1 = __builtin_amdgcn_mfma_f32_32x32x16_bf16(vb8, pf, o1, 0, 0, 0); \
                osum = __builtin_amdgcn_mfma_f32_32x32x16_bf16(ones, pf, osum, 0, 0, 0); } \
        BG_PACK(bg, lane, bs_); \
        if (more2) ATT_LSTORE(bfree); \
        BG_FLUSH(bg, lane); \
        asm volatile("s_waitcnt lgkmcnt(0)" ::: "memory"); __builtin_amdgcn_s_barrier(); asm volatile("" ::: "memory");        \
        if (MK_ATT_STAGGER > 0 && wid >= 4) __builtin_amdgcn_s_sleep(MK_ATT_STAGGER);        \
        { const int tb = bcur; bcur = bnxt; bnxt = bfree; bfree = tb; } } while (0)
    for (int t = 0; t < NT; t += 2) {
        ATT_STEP(s0, s1, n0, n1, t, bgA, bgB);
        ATT_STEP(n0, n1, s0, s1, t + 1, bgB, bgA);
    }
#undef ATT_STEP
#undef ATT_GLOAD
#undef ATT_LSTORE
#undef ATT_QK
    const float lsum = osum[0];
    const bool bad = !(lsum > 1e-30f && lsum < 1e30f);
    const float inv = __builtin_amdgcn_rcpf(lsum);
    unsigned char* orow = O + (size_t)(wid * 32 + r32) * opitch;
#pragma unroll
    for (int i = 0; i < 4; ++i) {
        *(unsigned*)(orow + 8 * i + 4 * hi) = pk4_fp8(o0[4 * i] * (inv * FP8_SH), o0[4 * i + 1] * (inv * FP8_SH), o0[4 * i + 2] * (inv * FP8_SH), o0[4 * i + 3] * (inv * FP8_SH));
        *(unsigned*)(orow + 32 + 8 * i + 4 * hi) = pk4_fp8(o1[4 * i] * (inv * FP8_SH), o1[4 * i + 1] * (inv * FP8_SH), o1[4 * i + 2] * (inv * FP8_SH), o1[4 * i + 3] * (inv * FP8_SH));
    }
    return __any(bad) != 0;
}

__device__ __forceinline__ void p5_attention(const Frame& F) {
    const bf16_t* Qm = (const bf16_t*)(F.ws + WS_QM); const unsigned char* Km = (const unsigned char*)(F.ws + WS_KM); const bf16_t* Vm = (const bf16_t*)(F.ws + WS_VM);
    const bf16_t* Qg = (const bf16_t*)(F.ws + WS_QG); const unsigned char* Kg = (const unsigned char*)(F.ws + WS_KG); const bf16_t* Vg = (const bf16_t*)(F.ws + WS_VG);
    unsigned char* O = (unsigned char*)(F.ws + WS_O);
    LAS char* lds = (LAS char*)F.lds; volatile LAS unsigned* flag = (volatile LAS unsigned*)(F.lds + 140 * 1024);
    const int vcu = (F.G % 8 == 0) ? (F.bid % 8) * (F.G / 8) + F.bid / 8 : F.bid;
    BgCvt bg; bg.wgu = inp(I_WGU); bg.wdn = inp(I_WDN); bg.tgu = (unsigned char*)(F.ws + WS_WGU); bg.tdn = (unsigned char*)(F.ws + WS_WDN);
    bg.scr = (LAS unsigned*)(F.lds + BG_LDS_OFF + F.wave * 8448); bg.step = 0; bg.pitem = -1; bg.pstep = 0;
    float bgA[8], bgB[8];
#pragma unroll
    for (int i = 0; i < 8; ++i) { bgA[i] = 0.f; bgB[i] = 0.f; }
    { const int gwv = F.bid * NWAVES + F.wave, per = (BG_TOTAL + F.G * NWAVES - 1) / (F.G * NWAVES); bg.item = gwv * per; bg.end = (gwv + 1) * per < BG_TOTAL ? (gwv + 1) * per : BG_TOTAL; }
    for (int u = vcu; u < 1024 + 64; u += F.G) {
        int type, b, hd, qt, NT;
        if (u < 1024) { type = u >> 9; const int idx = u & 511; b = idx >> 7; hd = (idx >> 4) & 7; qt = 1 + (idx & 15); NT = TPB / 64; }
        else { const int idx = u - 1024; type = idx >> 5; b = (idx >> 3) & 3; hd = idx & 7; qt = 0; NT = CTXL / 64; }
        const size_t qrow = (size_t)b * TPB + 256 * qt, krow = (size_t)b * TPB;
        const float* rope = qt > 0 ? (const float*)(F.ws + WS_ROPEM) + (size_t)(qt - 1) * 256 * 32 : nullptr;
        unsigned redo = 1u;
        int tidu = F.tid; asm volatile("" : "+v"(tidu));
        if (qt > 0) {
            if (F.tid == 0) *flag = 0u;
            bool bad;
            if (type == 0) bad = attn_unit_fast<96>(Qm + qrow * 768 + hd * 96, 768, Km + krow * 768 + hd * 96, 768, Vm + krow * 512 + hd * 64, 512, O + qrow * D + hd * 64, D, NT, lds, tidu, rope, bg, bgA, bgB);
            else bad = attn_unit_fast<64>(Qg + qrow * 512 + hd * 64, 512, Kg + krow * 128 + (hd >> 2) * 64, 128, Vg + krow * 128 + (hd >> 2) * 64, 128, O + qrow * D + 512 + hd * 64, D, NT, lds, tidu, nullptr, bg, bgA, bgB);
            if (bad && F.lane == 0) *flag = 1u;
            __syncthreads();
            redo = *flag;
            __syncthreads();
        }
        if (redo) {
            if (type == 0) attn_unit<96>(Qm + qrow * 768 + hd * 96, 768, Km + krow * 768 + hd * 96, 768, Vm + krow * 512 + hd * 64, 512, O + qrow * D + hd * 64, D, NT, lds, tidu, rope);
            else attn_unit<64>(Qg + qrow * 512 + hd * 64, 512, Kg + krow * 128 + (hd >> 2) * 64, 128, Vg + krow * 128 + (hd >> 2) * 64, 128, O + qrow * D + 512 + hd * 64, D, NT, lds, tidu, nullptr);
        }
    }
    while (bg.item < bg.end || bg.pitem >= 0) { BG_LOAD(bg, F.lane, bgA); BG_PACK(bg, F.lane, bgB); BG_FLUSH(bg, F.lane); BG_LOAD(bg, F.lane, bgB); BG_PACK(bg, F.lane, bgA); BG_FLUSH(bg, F.lane); }
}
constexpr int RSTR = 36;
__device__ __forceinline__ void p7_router(const Frame& F, int layer, const bf16_t* X, bool lat_only, unsigned* rdy, unsigned* cnt) {
    LAS float* wl = (LAS float*)F.lds;
    LAS float* wsc = (LAS float*)(F.lds + 1024 * RSTR * 4) + F.wave * 48;
    LAS unsigned char* rowb = (LAS unsigned char*)(F.lds + 1024 * RSTR * 4 + 8 * 48 * 4) + F.wave * 1024;
    const float* WR = inp(I_WROUTER) + (size_t)layer * D * NE; const float* BR = inp(I_BROUTER) + layer * NE;
    { f32x4 wv[16];
#pragma unroll
      for (int k = 0; k < 16; ++k) { const int i = F.tid + k * NTHREADS; wv[k] = *(const f32x4*)(WR + (size_t)(i >> 3) * NE + (i & 7) * 4); }
      __builtin_amdgcn_sched_barrier(0);
#pragma unroll
      for (int k = 0; k < 16; ++k) { const int i = F.tid + k * NTHREADS; *(LAS f32x4*)(wl + (i >> 3) * RSTR + (i & 7) * 4) = wv[k]; } }
    __syncthreads();
    const int gw = F.bid * NWAVES + F.wave, NGW = F.G * NWAVES, lane = F.lane;
    const float* gn = inp(I_NORMG) + (size_t)(layer * 2 + 1) * D;
    unsigned char* X8 = (unsigned char*)(F.ws + WS_X8); int* TE = (int*)(F.ws + WS_TOPE); int* TP = (int*)(F.ws + WS_TOPP); float* TW = (float*)(F.ws + WS_TOPW);
    const int nrows = lat_only ? NBATCH * SEQ : MR;
    const int per = (nrows + NGW - 1) / NGW;
    float gm[16], shv[16]; int curv = -1;
    bool have_prev = false; int pe = 0, pr = 0; float pw = 0.f; unsigned ppos = 0u; u32x4 prow = (u32x4){0u, 0u, 0u, 0u};
    int a0 = gw * per, na = min(per, max(nrows - a0, 0)), b0 = 0, nb = 0;
    int ea0 = F.bid * NWAVES * per, ea1 = min(ea0 + NWAVES * per, nrows), lb0 = 0, lb1 = 0;
    if (rdy != nullptr && F.G == 256) {
        if (F.bid < 16) { na = 0; nb = 1; b0 = 16384 + 896 + gw; ea0 = ea1 = 0; lb0 = 16384 + 896 + F.bid * 8; lb1 = lb0 + 8; }
        else { const int lw = gw - 128, lw0 = (F.bid - 16) * 8; a0 = lw * 8 + min(lw, 1024); na = 8 + (lw < 1024 ? 1 : 0); nb = lw >= 1024 ? 1 : 0; b0 = 16384 + (lw - 1024);
               ea0 = lw0 * 8 + min(lw0, 1024); ea1 = (lw0 + 8) * 8 + min(lw0 + 8, 1024); if (lw0 >= 1024) { lb0 = 16384 + lw0 - 1024; lb1 = lb0 + 8; } }
    }
    if (rdy != nullptr) { if (F.tid == 0) wait_rows_ready(rdy, ea0, ea1, 4u); __syncthreads(); }
    for (int it = 0; it < na + nb; ++it) {
        const int q = it < na ? a0 + it : b0;
        if (rdy != nullptr && nb != 0 && it == na) { __syncthreads(); if (F.tid == 0) wait_rows_ready(rdy, lb0, lb1, 4u); __syncthreads(); }
        const int r = lat_only ? (q / SEQ) * TPB + CTXL + (q % SEQ) : q;
        { const int b = r / TPB, tp = r - b * TPB; const int v = tp < CTXL ? 4 : b;
          if (v != curv) { curv = v; const float* sh = mod_vec(F, layer, r, 3); const float* sc = mod_vec(F, layer, r, 4);
#pragma unroll
              for (int j = 0; j < 16; ++j) { const int c = lane + 64 * j; gm[j] = gn[c] * (1.f + sc[c]); shv[j] = sh[c]; } } }
        const bf16_t* xr = X + (size_t)r * D;
        float x[16]; float s = 0.f;
#pragma unroll
        for (int j = 0; j < 16; ++j) { x[j] = bf2f(xr[lane + 64 * j]); s += x[j] * x[j]; }
        const float inv = rsqrtf(wave_sum(s) * (1.0f / D) + EPS);
        float lg[32];
#pragma unroll
        for (int e = 0; e < 32; ++e) lg[e] = 0.f;
        f32x4 wa[8], wb[8];
#pragma unroll
        for (int q4 = 0; q4 < 8; ++q4) wa[q4] = *(const LAS f32x4*)(wl + lane * RSTR + q4 * 4);
#pragma unroll
        for (int j = 0; j < 16; ++j) { const int c = lane + 64 * j; const float h = x[j] * inv * gm[j] + shv[j];
            rowb[c] = (unsigned char)(pk4_fp8(h * FP8_SH, 0.f, 0.f, 0.f) & 0xffu);
            if (j < 15) {
#pragma unroll
                for (int q4 = 0; q4 < 8; ++q4) wb[q4] = *(const LAS f32x4*)(wl + (c + 64) * RSTR + q4 * 4); }
            __builtin_amdgcn_sched_group_barrier(0x100, 8, 0);
#pragma unroll
            for (int q4 = 0; q4 < 8; ++q4) { lg[q4 * 4 + 0] += h * wa[q4].x; lg[q4 * 4 + 1] += h * wa[q4].y; lg[q4 * 4 + 2] += h * wa[q4].z; lg[q4 * 4 + 3] += h * wa[q4].w; }
            __builtin_amdgcn_sched_group_barrier(0x2, 40, 0);
#pragma unroll
            for (int q4 = 0; q4 < 8; ++q4) wa[q4] = wb[q4]; }
        float v16[16], v8[8], v4[4], v2[2], v1;
        { const bool up = (lane & 32) != 0;
#pragma unroll
          for (int i = 0; i < 16; ++i) { const float keep = up ? lg[i + 16] : lg[i], give = up ? lg[i] : lg[i + 16]; v16[i] = keep + __shfl_xor(give, 32); } }
        { const bool up = (lane & 16) != 0;
#pragma unroll
          for (int i = 0; i < 8; ++i) { const float keep = up ? v16[i + 8] : v16[i], give = up ? v16[i] : v16[i + 8]; v8[i] = keep + __shfl_xor(give, 16); } }
        { const bool up = (lane & 8) != 0;
#pragma unroll
          for (int i = 0; i < 4; ++i) { const float keep = up ? v8[i + 4] : v8[i], give = up ? v8[i] : v8[i + 4]; v4[i] = keep + __shfl_xor(give, 8); } }
        { const bool up = (lane & 4) != 0;
#pragma unroll
          for (int i = 0; i < 2; ++i) { const float keep = up ? v4[i + 2] : v4[i], give = up ? v4[i] : v4[i + 2]; v2[i] = keep + __shfl_xor(give, 4); } }
        { const bool up = (lane & 2) != 0; const float keep = up ? v2[1] : v2[0], give = up ? v2[0] : v2[1]; v1 = keep + __shfl_xor(give, 2); }
        v1 += __shfl_xor(v1, 1);
        const int e = lane >> 1; const float logit = v1 + BR[e];
        if ((lane & 1) == 0) wsc[e] = logit;
        LDS_WAIT();
        int rank = 0;
#pragma unroll
        for (int k = 0; k < 32; ++k) { const float o = wsc[k]; rank += (o > logit || (o == logit && k < e)) ? 1 : 0; }
        if ((lane & 1) == 0 && rank < 4) { wsc[32 + rank] = __int_as_float(e); wsc[36 + rank] = logit; }
        LDS_WAIT();
        const u32x4 rowv = *(const LAS u32x4*)(rowb + 16 * lane);
        float wk = 0.f; int ek = 0;
        if (lane < 4) { const float l0 = wsc[36], l1 = wsc[37], l2 = wsc[38], l3 = wsc[39]; const float me = wsc[36 + lane]; ek = __float_as_int(wsc[32 + lane]);
            const float den = 1.f + __expf(l1 - l0) + __expf(l2 - l0) + __expf(l3 - l0); wk = __expf(me - l0) * __builtin_amdgcn_rcpf(den); }
        LDS_WAIT();
#define ROUTER_FINISH() do { if (lane < 4) { TE[pr * 4 + lane] = pe; TP[pr * 4 + lane] = (int)ppos; TW[pr * 4 + lane] = pw; wsc[40 + lane] = __int_as_float((int)(pe * MR + ppos)); } \
            LDS_WAIT(); _Pragma("unroll") for (int k = 0; k < 4; ++k) { const int slot = __float_as_int(wsc[40 + k]); *(u32x4*)(X8 + (size_t)slot * D + 16 * lane) = prow; } LDS_WAIT(); } while (0)
        if (have_prev) ROUTER_FINISH();
        if (lane < 4) ppos = atomicAdd(cnt + 64 * ek, 1u);
        pe = ek; pw = wk; pr = r; prow = rowv; have_prev = true;
    }
    if (have_prev) ROUTER_FINISH();
#undef ROUTER_FINISH
    __syncthreads();
}

template <bool FINAL>
__device__ __forceinline__ void p_combine(const Frame& F, int layer, const bf16_t* XI, void* XOv, const unsigned* cnt) {
    LAS int* tab = (LAS int*)F.lds;
    moe_table(F, cnt, tab);
    const float* fing_ = inp(I_FINALG); const float* nng_ = inp(I_NORMG) + (size_t)((layer + 1) * 2) * D;
    const int gw = F.bid * NWAVES + F.wave, NGW = F.G * NWAVES, lane = F.lane;
    const int* TE = (const int*)(F.ws + WS_TOPE); const int* TP = (const int*)(F.ws + WS_TOPP); const float* TW = (const float*)(F.ws + WS_TOPW); const unsigned char* YS = (const unsigned char*)(F.ws + WS_YS);
    const int nrows = FINAL ? NBATCH * SEQ : MR;
    typedef int i32x4 __attribute__((ext_vector_type(4)));
    const int q0 = gw;
    i32x4 ne = {}, np = {}; f32x4 nw = {};
    if (q0 < nrows) { const int r0 = FINAL ? (q0 / SEQ) * TPB + CTXL + (q0 % SEQ) : q0; ne = *(const i32x4*)(TE + r0 * 4); np = *(const i32x4*)(TP + r0 * 4); nw = *(const f32x4*)(TW + r0 * 4); }
    for (int q = gw; q < nrows; q += NGW) {
        const int r = FINAL ? (q / SEQ) * TPB + CTXL + (q % SEQ) : q;
        const float* g2 = mod_vec(F, layer, r, 5);
        const i32x4 ce = ne, cp = np; const f32x4 cw = nw;
        { const int qn = q + NGW; if (qn < nrows) { const int rn = FINAL ? (qn / SEQ) * TPB + CTXL + (qn % SEQ) : qn; ne = *(const i32x4*)(TE + rn * 4); np = *(const i32x4*)(TP + rn * 4); nw = *(const f32x4*)(TW + rn * 4); } }
        unsigned yv[4][4]; u32x2 xv[4]; f32x4 gv[4];
#pragma unroll
        for (int k = 0; k < 4; ++k) { const int row = tab[33 + ce[k]] + cp[k]; const unsigned char* yr = YS + (size_t)row * D;
#pragma unroll
            for (int j = 0; j < 4; ++j) yv[k][j] = *(const unsigned*)(yr + 4 * lane + 256 * j); }
#pragma unroll
        for (int j = 0; j < 4; ++j) { const int c = 4 * lane + 256 * j; xv[j] = *(const u32x2*)(XI + (size_t)r * D + c); gv[j] = *(const f32x4*)(g2 + c); }
        __builtin_amdgcn_sched_barrier(0);
        f32x4 f[4];
#pragma unroll
        for (int j = 0; j < 4; ++j) f[j] = (f32x4){0.f, 0.f, 0.f, 0.f};
#pragma unroll
        for (int k = 0; k < 4; ++k) {
#pragma unroll
            for (int j = 0; j < 4; ++j) { const f32x2 lo = __builtin_amdgcn_cvt_pk_f32_fp8((int)yv[k][j], false), hi = __builtin_amdgcn_cvt_pk_f32_fp8((int)yv[k][j], true); f[j] += (f32x4){lo.x, lo.y, hi.x, hi.y} * (cw[k] * (1.0f / FP8_SY)); } }
        f32x4 v[4];
#pragma unroll
        for (int j = 0; j < 4; ++j) v[j] = (f32x4){bflo(xv[j].x), bfhi(xv[j].x), bflo(xv[j].y), bfhi(xv[j].y)} + gv[j] * f[j];
        if (FINAL) {
            float s = 0.f;
#pragma unroll
            for (int j = 0; j < 4; ++j) s += (v[j].x * v[j].x + v[j].y * v[j].y) + (v[j].z * v[j].z + v[j].w * v[j].w);
            const float inv = rsqrtf(wave_sum(s) * (1.0f / D) + EPS);
            float* orow = (float*)XOv + (size_t)q * D;
#pragma unroll
            for (int j = 0; j < 4; ++j) { const int c = 4 * lane + 256 * j; *(f32x4*)(orow + c) = v[j] * inv * *(const f32x4*)(fing_ + c); }
        } else {
#pragma unroll
            for (int j = 0; j < 4; ++j) *(u32x2*)((bf16_t*)XOv + (size_t)r * D + 4 * lane + 256 * j) = (u32x2){cvtpk(v[j].x, v[j].y), cvtpk(v[j].z, v[j].w)};
            norm_mod_store8(v, nng_, mod_vec(F, layer + 1, r, 0), mod_vec(F, layer + 1, r, 1), (unsigned char*)(F.ws + WS_H) + (size_t)r * D, lane);
        }
    }
    __syncthreads();
}
__device__ __forceinline__ void p12_ssd_prep(const Frame& F) {
    const bf16_t* XR = (const bf16_t*)(F.ws + WS_XBCRAW); bf16_t* XB = (bf16_t*)(F.ws + WS_XBC);
    const float* cw = inp(I_SCONVW); const float* cb = inp(I_SCONVB);
    constexpr int RS = 26, NSEG = (MR + RS - 1) / RS;
    for (int task = F.bid * NTHREADS + F.tid; task < NSEG * (XBC / 8); task += F.G * NTHREADS) {
        const int seg = task / (XBC / 8), c8 = (task % (XBC / 8)) * 8; const int r0 = seg * RS;
        u32x4 xin[RS + 4];
#pragma unroll
        for (int i = 0; i < RS + 4; ++i) { int rr = r0 + i - 2; rr = rr < 0 ? 0 : (rr >= MR ? MR - 1 : rr); xin[i] = *(const u32x4*)(XR + (size_t)rr * XBC + c8); }
        f32x4 w[5][2];
#pragma unroll
        for (int k = 0; k < 5; ++k) { w[k][0] = *(const f32x4*)(cw + k * XBC + c8); w[k][1] = *(const f32x4*)(cw + k * XBC + c8 + 4); }
        const f32x4 b0 = *(const f32x4*)(cb + c8), b1 = *(const f32x4*)(cb + c8 + 4);
        __builtin_amdgcn_sched_barrier(0);
#pragma unroll
        for (int i = 0; i < RS; ++i) { const int r = r0 + i; if (r < MR) {
            const int tp = r % TPB; const int lo = tp < CTXL ? 0 : CTXL, hiE = tp < CTXL ? CTXL : TPB;
            f32x4 a0 = b0, a1 = b1;
#pragma unroll
            for (int k = 0; k < 5; ++k) { const int t2 = tp + k - 2; const float m = (t2 >= lo && t2 < hiE) ? 1.f : 0.f; const u32x4 x = xin[i + k];
                a0 += (f32x4){bflo(x.x), bfhi(x.x), bflo(x.y), bfhi(x.y)} * (w[k][0] * m); a1 += (f32x4){bflo(x.z), bfhi(x.z), bflo(x.w), bfhi(x.w)} * (w[k][1] * m); }
            *(u32x4*)(XB + (size_t)r * XBC + c8) = (u32x4){cvtpk(silu_f(a0.x), silu_f(a0.y)), cvtpk(silu_f(a0.z), silu_f(a0.w)), cvtpk(silu_f(a1.x), silu_f(a1.y)), cvtpk(silu_f(a1.z), silu_f(a1.w))}; } }
    }
    const float* DTR = (const float*)(F.ws + WS_DTRAW); float* DT = (float*)(F.ws + WS_DT); const float* dtb_ = inp(I_DTBIAS);
    for (int i = F.bid * NTHREADS + F.tid; i < MR * 32; i += F.G * NTHREADS) {
        const int r = i >> 5, dh = i & 31; const float x = DTR[(size_t)r * 16 + (dh & 15)] + dtb_[dh];
        DT[i] = x > 20.f ? x : log1pf(__expf(x));
    }
}

__device__ __forceinline__ int opaque(int v) { asm volatile("" : "+v"(v)); return v; }
__device__ __forceinline__ bf16x8 frag_row(const LAS char* base, int stride, int row0, int k0, int r32, int hi) { return *(const LAS bf16x8*)(base + (row0 + r32) * stride + (k0 + 8 * hi) * 2); }
template <bool PERM> __device__ __forceinline__ bf16x8 frag_tr(const LAS char* base, int stride, int k0, int col0, int lane) {
    const int hi = lane >> 5, q4 = (lane & 15) >> 2; const int ra = PERM ? (4 * hi + q4) : (8 * hi + q4), rb = PERM ? (8 + 4 * hi + q4) : (8 * hi + 4 + q4);
    const int cb = (col0 + ((lane >> 4) & 1) * 16 + (lane & 3) * 4) * 2;
    const s16x4 a = tr_read(base + (k0 + ra) * stride + cb), b = tr_read(base + (k0 + rb) * stride + cb);
    return (bf16x8){a[0], a[1], a[2], a[3], b[0], b[1], b[2], b[3]};
}
__device__ __forceinline__ int crow(int r, int hi) { return (r & 3) + 8 * (r >> 2) + 4 * hi; }

constexpr int S_BSTR = 272, S_XSTR = 144;
constexpr int S_B = 0, S_C = 128 * S_BSTR, S_X = 2 * 128 * S_BSTR, S_ST = S_X + 128 * S_XSTR;
constexpr int S_ACS = S_ST + 2 * 64 * S_BSTR, S_DTL = S_ACS + 16 * 128 * 4, S_END = S_DTL + 16 * 128 * 4;
static_assert(S_END <= MISC_OFF, "SSD LDS map");

__device__ __forceinline__ void ssd_tables(const Frame& F, int row0, int g) {
    LAS float* acs = (LAS float*)(F.lds + S_ACS); LAS float* dtl = (LAS float*)(F.lds + S_DTL);
    const float* DT = (const float*)(F.ws + WS_DT);
    const int tid = opaque(F.tid); const int combo = tid >> 5, j = tid & 31, dir = combo >> 3, hh = combo & 7, head = g * 8 + hh;
    const float a = -__expf(inp(I_ALOG)[dir * 16 + head]);
    float d[4], c[4]; float run = 0.f;
#pragma unroll
    for (int i = 0; i < 4; ++i) { const int s = 4 * j + i; const int l = dir ? 127 - s : s; d[i] = DT[(size_t)(row0 + l) * 32 + dir * 16 + head]; run += d[i] * a; c[i] = run; }
    float tot = run;
#pragma unroll
    for (int o = 1; o < 32; o <<= 1) { const float t = __shfl_up(tot, o, 32); if (j >= o) tot += t; }
    const float excl = tot - run;
#pragma unroll
    for (int i = 0; i < 4; ++i) { const int s = 4 * j + i; const int l = dir ? 127 - s : s; acs[combo * 128 + l] = c[i] + excl; dtl[combo * 128 + l] = d[i]; }
    __syncthreads();
}
__device__ __forceinline__ void stage_tile(const Frame& F, const bf16_t* g, int gp, LAS char* dst, int stride, int ncol8) {
#pragma unroll 1
    for (int i = opaque(F.tid); i < 128 * ncol8; i += NTHREADS) { const int r = i / ncol8, c = i % ncol8; *(LAS u32x4*)(dst + r * stride + c * 16) = *(const u32x4*)(g + (size_t)r * gp + c * 8); }
}

__device__ __forceinline__ void stage_tile64(const Frame& F, const bf16_t* g, LAS char* dst) {
#pragma unroll 1
    for (int i = opaque(F.tid); i < 64 * 16; i += NTHREADS) { const int r = i >> 4, c = i & 15; *(LAS u32x4*)(dst + r * S_BSTR + c * 16) = *(const u32x4*)(g + (size_t)r * 128 + c * 8); }
}
__device__ __forceinline__ void p13_chunk_states(const Frame& F) {
    const bf16_t* XB = (const bf16_t*)(F.ws + WS_XBC); bf16_t* CH = (bf16_t*)(F.ws + WS_CHST); float* AE = (float*)(F.ws + WS_AEND);
    LAS char* lds = (LAS char*)F.lds; LAS float* acs = (LAS float*)(F.lds + S_ACS); LAS float* dtl = (LAS float*)(F.lds + S_DTL);
    const int lane = F.lane, wave = F.wave, r32 = lane & 31, hi = lane >> 5;
    constexpr int NU = NBATCH * NCHUNK * 2, NFULL = NU - 16, NITEM = NFULL + 16 * 8;
    for (int item = F.bid; item < NITEM; item += F.G) {
        const int u = item < NFULL ? item : NFULL + ((item - NFULL) >> 3); const int hh0 = item < NFULL ? 0 : ((item - NFULL) & 7), hh1 = item < NFULL ? 8 : hh0 + 1;
        const int b = u / (NCHUNK * 2), c = (u >> 1) % NCHUNK, g = u & 1; const int row0 = b * TPB + c * 128;
        __syncthreads();
        ssd_tables(F, row0, g);
        stage_tile(F, XB + (size_t)row0 * XBC + 1024 + g * 128, XBC, lds + S_B, S_BSTR, 16);
        const int xl = F.tid >> 2, xpc = (F.tid & 3) * 16;
        u32x4 nx0, nx1;
        { const bf16_t* xp = XB + (size_t)(row0 + xl) * XBC + (g * 8 + hh0) * 64 + xpc; nx0 = *(const u32x4*)xp; nx1 = *(const u32x4*)(xp + 8); }
#pragma unroll 1
        for (int hh = hh0; hh < hh1; ++hh) {
            const int head = g * 8 + hh; const u32x4 x0 = nx0, x1 = nx1;
            if (hh + 1 < hh1) { const bf16_t* xp = XB + (size_t)(row0 + xl) * XBC + (head + 1) * 64 + xpc; nx0 = *(const u32x4*)xp; nx1 = *(const u32x4*)(xp + 8); }
#pragma unroll 1
            for (int dir = 0; dir < 2; ++dir) {
                const int combo = dir * 8 + hh;
                const float aend = acs[combo * 128 + (dir ? 0 : 127)];
                __syncthreads();
                { const float w = dtl[combo * 128 + xl] * __expf(aend - acs[combo * 128 + xl]);
                  *(LAS u32x4*)(lds + S_X + xl * S_XSTR + xpc * 2) = (u32x4){cvtpk(bflo(x0.x) * w, bfhi(x0.x) * w), cvtpk(bflo(x0.y) * w, bfhi(x0.y) * w), cvtpk(bflo(x0.z) * w, bfhi(x0.z) * w), cvtpk(bflo(x0.w) * w, bfhi(x0.w) * w)};
                  *(LAS u32x4*)(lds + S_X + xl * S_XSTR + xpc * 2 + 16) = (u32x4){cvtpk(bflo(x1.x) * w, bfhi(x1.x) * w), cvtpk(bflo(x1.y) * w, bfhi(x1.y) * w), cvtpk(bflo(x1.z) * w, bfhi(x1.z) * w), cvtpk(bflo(x1.w) * w, bfhi(x1.w) * w)}; }
                __syncthreads();
                const int pb = wave & 1, nb = wave >> 1; f32x16 acc = {};
#pragma unroll
                for (int ks = 0; ks < 8; ++ks) { const bf16x8 fa = frag_tr<false>(lds + S_X, S_XSTR, 16 * ks, 32 * pb, lane), fb = frag_tr<false>(lds + S_B, S_BSTR, 16 * ks, 32 * nb, lane);
                    acc = __builtin_amdgcn_mfma_f32_32x32x16_bf16(fb, fa, acc, 0, 0, 0); }
                bf16_t* out = CH + ((((size_t)b * 2 + dir) * 16 + head) * NCHUNK + c) * 8192;
#pragma unroll
                for (int i = 0; i < 4; ++i) *(u32x2*)(out + (32 * pb + r32) * 128 + 32 * nb + 8 * i + 4 * hi) = (u32x2){cvtpk(acc[4 * i], acc[4 * i + 1]), cvtpk(acc[4 * i + 2], acc[4 * i + 3])};
                if (F.tid == 0) AE[(((size_t)b * 2 + dir) * 16 + head) * NCHUNK + c] = aend;
            }
        }
    }
    __syncthreads();
}

__device__ __forceinline__ void p14_scan(const Frame& F) {
    const bf16_t* CH = (const bf16_t*)(F.ws + WS_CHST); const float* AE = (const float*)(F.ws + WS_AEND); bf16_t* ST = (bf16_t*)(F.ws + WS_STIN);
    const int total = NBATCH * 2 * 16 * 2048;
    for (int i = F.bid * NTHREADS + F.tid; i < total; i += F.G * NTHREADS) {
        const int seq = i >> 11, e4 = (i & 2047) * 4; const int dir = (seq >> 4) & 1;
        const bf16_t* ch = CH + (size_t)seq * NCHUNK * 8192 + e4; bf16_t* st = ST + (size_t)seq * NCHUNK * 8192 + e4; const float* ae = AE + (size_t)seq * NCHUNK;
        f32x4 s = (f32x4){0.f, 0.f, 0.f, 0.f};
        u32x2 nv[NCHUNK]; float av[NCHUNK];
#pragma unroll
        for (int k = 0; k < NCHUNK; ++k) { const int c = dir ? (k < 2 ? 1 - k : NCHUNK + 1 - k) : k; nv[k] = *(const u32x2*)(ch + (size_t)c * 8192); av[k] = ae[c]; }
        __builtin_amdgcn_sched_barrier(0);
#pragma unroll
        for (int k = 0; k < NCHUNK; ++k) { const int c = dir ? (k < 2 ? 1 - k : NCHUNK + 1 - k) : k;
            if (c >= 2) *(u32x2*)(st + (size_t)c * 8192) = (u32x2){cvtpk(s.x, s.y), cvtpk(s.z, s.w)};
            s = s * __expf(av[k]) + (f32x4){bflo(nv[k].x), bfhi(nv[k].x), bflo(nv[k].y), bfhi(nv[k].y)}; }
    }
}

__device__ __forceinline__ void p15_ssd_out(const Frame& F) {
    const bf16_t* XB = (const bf16_t*)(F.ws + WS_XBC); const bf16_t* ST = (const bf16_t*)(F.ws + WS_STIN); const bf16_t* Z = (const bf16_t*)(F.ws + WS_Z); bf16_t* GT = (bf16_t*)(F.ws + WS_O);
    LAS char* lds = (LAS char*)F.lds; LAS float* acs = (LAS float*)(F.lds + S_ACS); LAS float* dtl = (LAS float*)(F.lds + S_DTL);
    const int lane = F.lane, wave = F.wave, r32 = lane & 31, hi = lane >> 5; const int lb = wave & 3, ph = wave >> 2; const float* sd_ = inp(I_SD);
    for (int u = F.bid; u < NBATCH * 32 * 2; u += F.G) {
        const int b = u >> 6, c = 2 + ((u >> 1) & 31), g = u & 1; const int row0 = b * TPB + c * 128;
        __syncthreads();
        ssd_tables(F, row0, g);
        stage_tile(F, XB + (size_t)row0 * XBC + 1024 + g * 128, XBC, lds + S_B, S_BSTR, 16);
        stage_tile(F, XB + (size_t)row0 * XBC + 1280 + g * 128, XBC, lds + S_C, S_BSTR, 16);
        __syncthreads();
        unsigned Sp[4][8];
#pragma unroll
        for (int sb = 0; sb < 4; ++sb) { f32x16 S = {};
#pragma unroll
            for (int ks = 0; ks < 8; ++ks) S = __builtin_amdgcn_mfma_f32_32x32x16_bf16(frag_row(lds + S_B, S_BSTR, 32 * sb, 16 * ks, r32, hi), frag_row(lds + S_C, S_BSTR, 32 * lb, 16 * ks, r32, hi), S, 0, 0, 0);
#pragma unroll
            for (int i = 0; i < 8; ++i) Sp[sb][i] = cvtpk(S[2 * i], S[2 * i + 1]); }
        const int l = 32 * lb + r32;
        u32x4 px[2], pst[4];
#define S3_PREFETCH(hd_) do { const int t_ = opaque(F.tid); \
            _Pragma("unroll") for (int i_ = 0; i_ < 2; ++i_) { const int q_ = t_ + 512 * i_; px[i_] = *(const u32x4*)(XB + (size_t)(row0 + (q_ >> 3)) * XBC + (hd_) * 64 + (q_ & 7) * 8); } \
            _Pragma("unroll") for (int i_ = 0; i_ < 4; ++i_) { const int q_ = t_ + 512 * i_; const int dir_ = q_ >> 10, rr_ = (q_ >> 4) & 63, cc_ = q_ & 15; \
                pst[i_] = *(const u32x4*)(ST + ((((size_t)b * 2 + dir_) * 16 + (hd_)) * NCHUNK + c) * 8192 + rr_ * 128 + cc_ * 8); } } while (0)
        S3_PREFETCH(g * 8);
#pragma unroll 1
        for (int hh = 0; hh < 8; ++hh) {
            const int head = g * 8 + hh;
            __syncthreads();
            { const int t_ = opaque(F.tid);
#pragma unroll
              for (int i_ = 0; i_ < 2; ++i_) { const int q_ = t_ + 512 * i_; *(LAS u32x4*)(lds + S_X + (q_ >> 3) * S_XSTR + (q_ & 7) * 16) = px[i_]; }
#pragma unroll
              for (int i_ = 0; i_ < 4; ++i_) { const int q_ = t_ + 512 * i_; const int dir_ = q_ >> 10, rr_ = (q_ >> 4) & 63, cc_ = q_ & 15; *(LAS u32x4*)(lds + S_ST + dir_ * 64 * S_BSTR + rr_ * S_BSTR + cc_ * 16) = pst[i_]; } }
            __syncthreads();
            if (hh < 7) S3_PREFETCH(head + 1);
            f32x16 y = {};
#pragma unroll 1
            for (int dir = 0; dir < 2; ++dir) {
                const int combo = dir * 8 + hh; const float al = acs[combo * 128 + l];
                const int lloc = opaque(r32);
                f32x16 yd = {};
#pragma unroll
                for (int sb = 0; sb < 4; ++sb) {
                    if (dir ? (sb >= lb) : (sb <= lb)) {
                        f32x16 p; const bool diag = (sb == lb);
#pragma unroll
                        for (int r = 0; r < 16; ++r) { const int sl = crow(r, hi); const int s = 32 * sb + sl;
                            float dec = dtl[combo * 128 + s] * __expf(al - acs[combo * 128 + s]);
                            if (diag) { const bool ok = dir ? (sl >= lloc) : (sl <= lloc); dec = ok ? dec : 0.f; }
                            p[r] = ((r & 1) ? bfhi(Sp[sb][r >> 1]) : bflo(Sp[sb][r >> 1])) * dec; }
#pragma unroll
                        for (int ks = 0; ks < 2; ++ks) {
                            const u32x4 pw = (u32x4){cvtpk(p[8 * ks], p[8 * ks + 1]), cvtpk(p[8 * ks + 2], p[8 * ks + 3]), cvtpk(p[8 * ks + 4], p[8 * ks + 5]), cvtpk(p[8 * ks + 6], p[8 * ks + 7])};
                            yd = __builtin_amdgcn_mfma_f32_32x32x16_bf16(frag_tr<true>(lds + S_X, S_XSTR, 32 * sb + 16 * ks, 32 * ph, lane), __builtin_bit_cast(bf16x8, pw), yd, 0, 0, 0);
                        }
                    }
                }
                f32x16 zo = {};
#pragma unroll
                for (int ks = 0; ks < 8; ++ks) zo = __builtin_amdgcn_mfma_f32_32x32x16_bf16(frag_row(lds + S_ST + dir * 64 * S_BSTR, S_BSTR, 32 * ph, 16 * ks, r32, hi), frag_row(lds + S_C, S_BSTR, 32 * lb, 16 * ks, r32, hi), zo, 0, 0, 0);
                const float ea = __expf(al);
#pragma unroll
                for (int r = 0; r < 16; ++r) y[r] += yd[r] + ea * zo[r];
            }
            const float dsk = sd_[head] + sd_[16 + head];
            const size_t grow = (size_t)(row0 + l);
#pragma unroll
            for (int i = 0; i < 4; ++i) { const int p0 = 32 * ph + 8 * i + 4 * hi;
                const u32x2 xv = *(const LAS u32x2*)(lds + S_X + l * S_XSTR + p0 * 2); const u32x2 zv = *(const u32x2*)(Z + grow * D + head * 64 + p0);
                const float o0 = (y[4 * i] + dsk * bflo(xv.x)) * silu_f(bflo(zv.x)), o1 = (y[4 * i + 1] + dsk * bfhi(xv.x)) * silu_f(bfhi(zv.x));
                const float o2 = (y[4 * i + 2] + dsk * bflo(xv.y)) * silu_f(bflo(zv.y)), o3 = (y[4 * i + 3] + dsk * bfhi(xv.y)) * silu_f(bfhi(zv.y));
                *(u32x2*)(GT + grow * D + head * 64 + p0) = (u32x2){cvtpk(o0, o1), cvtpk(o2, o3)}; }
        }
    }
#undef S3_PREFETCH
    __syncthreads();
}

__device__ __forceinline__ void p16_merge(const Frame& F) {
    const int gw = F.bid * NWAVES + F.wave, NGW = F.G * NWAVES, lane = F.lane;
    const bf16_t* GT = (const bf16_t*)(F.ws + WS_O); unsigned char* A3 = (unsigned char*)(F.ws + WS_A3);        const bf16_t* V = (const bf16_t*)(F.ws + WS_V);
    const float* sng_ = inp(I_SNORMG); const float* cdw_ = inp(I_CDWW); const float* clg_ = inp(I_CLNG); const float* clb_ = inp(I_CLNB);
    for (int q = gw; q < NBATCH * SEQ; q += NGW) {
        const int r = (q / SEQ) * TPB + CTXL + (q % SEQ);
        float x[16]; float s = 0.f;
#pragma unroll
        for (int j = 0; j < 4; ++j) { const u32x2 v = *(const u32x2*)(GT + (size_t)r * D + 4 * lane + 256 * j); x[4 * j] = bflo(v.x); x[4 * j + 1] = bfhi(v.x); x[4 * j + 2] = bflo(v.y); x[4 * j + 3] = bfhi(v.y); }
#pragma unroll
        for (int j = 0; j < 16; ++j) s += x[j] * x[j];
        const float inv = rsqrtf(wave_sum(s) * (1.0f / D) + EPS);
#pragma unroll
        for (int j = 0; j < 4; ++j) { const int c = 4 * lane + 256 * j; const f32x4 g = *(const f32x4*)(sng_ + c);
            *(unsigned*)(A3 + (size_t)r * 2048 + c) = pk4_fp8(x[4 * j] * inv * g.x * FP8_SH, x[4 * j + 1] * inv * g.y * FP8_SH, x[4 * j + 2] * inv * g.z * FP8_SH, x[4 * j + 3] * inv * g.w * FP8_SH); }
    }
    LAS float* cv = (LAS float*)F.lds;
    const int ch = 2 * F.tid;
    float w0[31], w1[31];
#pragma unroll
    for (int k = 0; k < 31; ++k) { const f32x2 w = *(const f32x2*)(cdw_ + (size_t)k * D + ch); w0[k] = w.x; w1[k] = w.y; }
    const f32x2 bias = *(const f32x2*)(inp(I_CDWB) + ch);
    for (int u = F.bid; u < NBATCH * (SEQ / 16); u += F.G) {
        const int b = u / (SEQ / 16), t0 = (u % (SEQ / 16)) * 16; const size_t rbase = (size_t)b * TPB + CTXL;
        float a0[16], a1[16];
#pragma unroll
        for (int j = 0; j < 16; ++j) { a0[j] = bias.x; a1[j] = bias.y; }
        unsigned xin[46];
#pragma unroll
        for (int i = 0; i < 46; ++i) { const int t = t0 + i - 15; const int tc = t < 0 ? 0 : (t >= SEQ ? SEQ - 1 : t); xin[i] = *(const unsigned*)(V + (rbase + tc) * D + ch); }
        __builtin_amdgcn_sched_barrier(0);
#pragma unroll
        for (int i = 0; i < 46; ++i) { const int t = t0 + i - 15; const unsigned xv = (t >= 0 && t < SEQ) ? xin[i] : 0u; const float x0 = bflo(xv), x1 = bfhi(xv);
#pragma unroll
            for (int j = 0; j < 16; ++j) { const int k = i - j; if (k >= 0 && k < 31) { a0[j] += w0[k] * x0; a1[j] += w1[k] * x1; } } }
        __syncthreads();
#pragma unroll
        for (int j = 0; j < 16; ++j) *(LAS f32x2*)(cv + j * 1024 + ch) = (f32x2){a0[j], a1[j]};
        __syncthreads();
#pragma unroll
        for (int jj = 0; jj < 2; ++jj) { const int j = F.wave * 2 + jj; f32x4 v[4]; float s = 0.f;
#pragma unroll
            for (int k = 0; k < 4; ++k) { v[k] = *(const LAS f32x4*)(cv + j * 1024 + 4 * lane + 256 * k); s += (v[k].x + v[k].y) + (v[k].z + v[k].w); }
            const float mu = wave_sum(s) * (1.0f / D); float s2 = 0.f;
#pragma unroll
            for (int k = 0; k < 4; ++k) { v[k] = v[k] - mu; s2 += (v[k].x * v[k].x + v[k].y * v[k].y) + (v[k].z * v[k].z + v[k].w * v[k].w); }
            const float rstd = rsqrtf(wave_sum(s2) * (1.0f / D) + EPS);
            unsigned char* orow = A3 + (rbase + t0 + j) * 2048 + 1024;
#pragma unroll
            for (int k = 0; k < 4; ++k) { const int c = 4 * lane + 256 * k; const f32x4 g = *(const f32x4*)(clg_ + c), bb = *(const f32x4*)(clb_ + c);
                const float y0 = silu_f(v[k].x * rstd * g.x + bb.x), y1 = silu_f(v[k].y * rstd * g.y + bb.y), y2 = silu_f(v[k].z * rstd * g.z + bb.z), y3 = silu_f(v[k].w * rstd * g.w + bb.w);
                *(unsigned*)(orow + c) = pk4_fp8(y0 * FP8_SH, y1 * FP8_SH, y2 * FP8_SH, y3 * FP8_SH); }
        }
    }
    __syncthreads();
}
#ifndef MK_PER_PHASE
#define MK_PER_PHASE 0
#endif
#ifndef MK_LAST_PHASE
#define MK_LAST_PHASE 22
#endif
#ifndef MK_MOE_SP2
#define MK_MOE_SP2 1
#endif
constexpr int N_PHASES = 22;
constexpr int TAB_OFF = 131072;
constexpr int MOE_KB = MK_FP8 ? 1024 : 2048;

__global__ void __launch_bounds__(NTHREADS, 2) fwd_kernel(Args args) {
    extern __shared__ __attribute__((aligned(16))) unsigned char lds_raw[];
    Frame F;
    F.lds = (LAS unsigned char*)lds_raw; F.ws = args.ws; F.ctl = (unsigned*)(args.ws + WS_CTL);
    F.tid = threadIdx.x; F.lane = F.tid & 63; F.wave = __builtin_amdgcn_readfirstlane(F.tid >> 6); F.G = gridDim.x; F.bid = blockIdx.x; F.x = args.in[I_X]; F.ctx = args.in[I_CTX];
    volatile LAS unsigned* MISC = (volatile LAS unsigned*)(F.lds + MISC_OFF);
    if (F.tid < 64) MISC[F.tid] = 0u;
    __syncthreads();
    XcdBarrier bar; bar.bar = F.ctl + CW_BAR; bar.x = 0; bar.st = nullptr;
    if (!MK_PER_PHASE) bar = xcd_barrier_post(F.ctl + CW_BAR, MISC + 8);
    const int lo = args.ph_lo, hi = args.ph_hi;
#ifndef MK_ONLY
#define MK_ONLY -1
#endif
#define IN(k) ((MK_ONLY < 0 || MK_ONLY == (k)) && lo <= (k) && (k) < hi)
#ifndef MK_REP_MASK
#define MK_REP_MASK 0
#endif
#define REP(k) _Pragma("unroll") for (int _rep = 0; _rep < 1 + ((MK_REP_MASK >> (k)) & 1); __syncthreads(), ++_rep)
#ifndef MK_BAR2
#define MK_BAR2 0
#endif
#define SEAM(k) do { if (IN(k) && IN((k) + 1)) { xcd_barrier(bar); if (MK_BAR2) xcd_barrier(bar); } } while (0)
    unsigned* cnt0 = F.ctl + CW_CNT0; unsigned* cnt1 = F.ctl + CW_CNT1;
    LAS int* tab = (LAS int*)(F.lds + TAB_OFF);

    if (IN(0)) REP(0) { F.tid = fresh_tid(F.wave); F.lane = F.tid & 63; p0_prologue(F); } SEAM(0);
    if (IN(1)) REP(1) { F.tid = fresh_tid(F.wave); F.lane = F.tid & 63; p1_norm_mod(F); } SEAM(1);
    if (IN(2)) REP(2) { F.tid = fresh_tid(F.wave); F.lane = F.tid & 63;
        DenseOrder S{(const char*)(F.ws + WS_H), (const char*)(F.ws + WS_WAIN), 1024, MR / 256, ATTN_INP / 256, F.G, F.bid, false, 0, 0, 0, 0, 0u, 51};
        EpiBf16 E{(bf16_t*)(F.ws + WS_U0), ATTN_INP, F.ctl + CW_RDY2};
        pg8::gemm_phase<EpiBf16, DenseOrder, false, true, 0, 0>(F.lds, 1024, S, E, F.tid);
    }
    if (IN(3)) REP(3) { F.tid = fresh_tid(F.wave); F.lane = F.tid & 63; p3_attn_post(F, F.ctl + CW_RDY2); } SEAM(3);
    if (IN(4)) REP(4) { F.tid = fresh_tid(F.wave); F.lane = F.tid & 63;
        DenseOrder S{(const char*)(F.ws + WS_CQKV), (const char*)(F.ws + WS_WUP), UPK * 2, MR / 256, UPN / 256, F.G, F.bid, false, 0, 0, 0, 0, 0u};
        EpiUp E{(bf16_t*)(F.ws + WS_QM), (unsigned char*)(F.ws + WS_KM), (bf16_t*)(F.ws + WS_VM)};
        pg8::gemm_phase<EpiUp, DenseOrder, false>(F.lds, UPK * 2, S, E, F.tid);
    } SEAM(4);
    if (IN(5)) REP(5) { F.tid = fresh_tid(F.wave); F.lane = F.tid & 63; p5_attention(F); } SEAM(5);
    if (IN(6)) REP(6) { F.tid = fresh_tid(F.wave); F.lane = F.tid & 63;
        DenseOrder S{(const char*)(F.ws + WS_O), (const char*)(F.ws + WS_WAOUT), 1024, MR / 256, 4, F.G, F.bid, false, 0, 0, 0, 0, 0u, 64};
        EpiResid<true> E{F, nullptr, (bf16_t*)(F.ws + WS_X1), 0, F.ctl + CW_RDY};
        pg8::gemm_phase<EpiResid<true>, DenseOrder, false, true, 0, 0>(F.lds, 1024, S, E, F.tid);
    }
    if (IN(7)) REP(7) { F.tid = fresh_tid(F.wave); F.lane = F.tid & 63; p7_router(F, 0, (const bf16_t*)(F.ws + WS_X1), false, F.ctl + CW_RDY, (((MK_REP_MASK >> 7) & 1) && _rep == 0) ? F.ctl + CW_CNT0 + 8192 : cnt0); } SEAM(7);
    if (IN(8)) REP(8) { F.tid = fresh_tid(F.wave); F.lane = F.tid & 63;
        moe_table(F, cnt0, tab);
        MoeOrder S{tab, (const char*)(F.ws + WS_X8), (const char*)(F.ws + WS_WGU), MOE_KB, 8, F.G, F.bid, true, (size_t)2048 * MOE_KB, 1};
        EpiSwiglu E{(unsigned char*)(F.ws + WS_ACT), inp(I_BGU)};
        pg8::gemm_phase<EpiSwiglu, MoeOrder, false, MK_FP8 != 0, 0, 0, MK_MOE_SP2 != 0, true>(F.lds, MOE_KB, S, E, F.tid);
    } SEAM(8);
    if (IN(9)) REP(9) { F.tid = fresh_tid(F.wave); F.lane = F.tid & 63;
        moe_table(F, cnt0, tab);
        MoeOrder S{tab, (const char*)(F.ws + WS_ACT), (const char*)(F.ws + WS_WDN), MOE_KB, 4, F.G, F.bid, false, (size_t)1024 * MOE_KB, 0};
        EpiYs E{(unsigned char*)(F.ws + WS_YS), inp(I_BDN)};
        pg8::gemm_phase<EpiYs, MoeOrder, false, MK_FP8 != 0, 0, 0, MK_MOE_SP2 != 0, true>(F.lds, MOE_KB, S, E, F.tid);
    } SEAM(9);
    if (IN(10)) REP(10) { F.tid = fresh_tid(F.wave); F.lane = F.tid & 63; p_combine<false>(F, 0, (const bf16_t*)(F.ws + WS_X1), (void*)(F.ws + WS_X2), cnt0); } SEAM(10);
    if (IN(11)) REP(11) { F.tid = fresh_tid(F.wave); F.lane = F.tid & 63;
        DenseOrder S{(const char*)(F.ws + WS_H), (const char*)(F.ws + WS_WSIN), 1024, 64, SSM_INP / 256, F.G, F.bid, true, 10, 2560, 3584, 8, (0x3fu << 4) | (1u << 18)};
        EpiSsmIn E{(bf16_t*)(F.ws + WS_Z), (bf16_t*)(F.ws + WS_XBCRAW), (bf16_t*)(F.ws + WS_V), (float*)(F.ws + WS_DTRAW)};
        pg8::gemm_phase<EpiSsmIn, DenseOrder, false, true, 0, 0>(F.lds, 1024, S, E, F.tid);
    } SEAM(11);
    if (IN(12)) REP(12) { F.tid = fresh_tid(F.wave); F.lane = F.tid & 63; p12_ssd_prep(F); } SEAM(12);
    if (IN(13)) REP(13) { F.tid = fresh_tid(F.wave); F.lane = F.tid & 63; p13_chunk_states(F); } SEAM(13);
    if (IN(14)) REP(14) { F.tid = fresh_tid(F.wave); F.lane = F.tid & 63; p14_scan(F); } SEAM(14);
    if (IN(15)) REP(15) { F.tid = fresh_tid(F.wave); F.lane = F.tid & 63; p15_ssd_out(F); } SEAM(15);
    if (IN(16)) REP(16) { F.tid = fresh_tid(F.wave); F.lane = F.tid & 63; p16_merge(F); } SEAM(16);
    if (IN(17)) REP(17) { F.tid = fresh_tid(F.wave); F.lane = F.tid & 63;
        DenseOrder S{(const char*)(F.ws + WS_A3), (const char*)(F.ws + WS_WSOUT), 2048, 64, 4, F.G, F.bid, true, 0, 0, 0, 0, 0u};
        EpiResid<false> E{F, (const bf16_t*)(F.ws + WS_X2), (bf16_t*)(F.ws + WS_X1), 1, nullptr};
        pg8::gemm_phase<EpiResid<false>, DenseOrder, false, true, 0, 0>(F.lds, 2048, S, E, F.tid);
    } SEAM(17);
    if (IN(18)) REP(18) { F.tid = fresh_tid(F.wave); F.lane = F.tid & 63; p7_router(F, 1, (const bf16_t*)(F.ws + WS_X1), true, nullptr, (((MK_REP_MASK >> 18) & 1) && _rep == 0) ? F.ctl + CW_CNT0 + 12288 : cnt1); } SEAM(18);
    if (IN(19)) REP(19) { F.tid = fresh_tid(F.wave); F.lane = F.tid & 63;
        moe_table(F, cnt1, tab);
        MoeOrder S{tab, (const char*)(F.ws + WS_X8), (const char*)(F.ws + WS_WGU + (size_t)32 * 2048 * MOE_KB), MOE_KB, 8, F.G, F.bid, true, (size_t)2048 * MOE_KB, 1};
        EpiSwiglu E{(unsigned char*)(F.ws + WS_ACT), inp(I_BGU) + (size_t)32 * 2048};
        pg8::gemm_phase<EpiSwiglu, MoeOrder, false, MK_FP8 != 0, 0, 0, MK_MOE_SP2 != 0, true>(F.lds, MOE_KB, S, E, F.tid);
    } SEAM(19);
    if (IN(20)) REP(20) { F.tid = fresh_tid(F.wave); F.lane = F.tid & 63;
        moe_table(F, cnt1, tab);
        MoeOrder S{tab, (const char*)(F.ws + WS_ACT), (const char*)(F.ws + WS_WDN + (size_t)32 * 1024 * MOE_KB), MOE_KB, 4, F.G, F.bid, false, (size_t)1024 * MOE_KB, 0};
        EpiYs E{(unsigned char*)(F.ws + WS_YS), inp(I_BDN) + (size_t)32 * 1024};
        pg8::gemm_phase<EpiYs, MoeOrder, false, MK_FP8 != 0, 0, 0, MK_MOE_SP2 != 0, true>(F.lds, MOE_KB, S, E, F.tid);
    } SEAM(20);
    if (IN(21)) REP(21) { F.tid = fresh_tid(F.wave); F.lane = F.tid & 63; p_combine<true>(F, 1, (const bf16_t*)(F.ws + WS_X1), (void*)args.out, cnt1); }
#undef IN
#undef SEAM
}

extern "C" void kernel_launch(void* const* d_in, const int* in_sizes, int n_in, void* d_out, int out_size, void* d_ws, size_t ws_size, hipStream_t stream) {
    static int grid = 0;
    if (grid == 0) {
        if (n_in != 34 || out_size != NBATCH * SEQ * D || ws_size < WS_END) { fprintf(stderr, "kernel_launch: unexpected problem (n_in %d, out %d, ws %zu < %zu); nothing launched\n", n_in, out_size, ws_size, (size_t)WS_END); grid = -1; return; }
        int dev = 0, cus = 0, per_cu = 0;
        if (hipGetDevice(&dev) != hipSuccess || hipDeviceGetAttribute(&cus, hipDeviceAttributeMultiprocessorCount, dev) != hipSuccess) { grid = -1; return; }
        if (hipFuncSetAttribute((const void*)fwd_kernel, hipFuncAttributeMaxDynamicSharedMemorySize, LDS_BYTES) != hipSuccess) { fprintf(stderr, "kernel_launch: hipFuncSetAttribute failed\n"); grid = -1; return; }
        if (hipOccupancyMaxActiveBlocksPerMultiprocessor(&per_cu, (const void*)fwd_kernel, NTHREADS, LDS_BYTES) != hipSuccess || per_cu < 1) { fprintf(stderr, "kernel_launch: occupancy query says %d\n", per_cu); }
        (void)hipGetLastError();
        grid = cus;
    }
    if (grid < 0) return;
    (void)hipMemsetAsync((char*)d_ws + WS_CTL, 0, CTL_ZERO_BYTES, stream);
    Args a{};
    for (int i = 0; i < 34; ++i) a.in[i] = (const float*)d_in[i];
    a.out = (float*)d_out; a.ws = (unsigned char*)d_ws;
#if MK_PER_PHASE
    for (int p = 0; p < MK_LAST_PHASE; ++p) { a.ph_lo = p; a.ph_hi = p + 1; hipLaunchKernelGGL(fwd_kernel, dim3(grid), dim3(NTHREADS), LDS_BYTES, stream, a); }
#else
    a.ph_lo = 0; a.ph_hi = MK_LAST_PHASE;
    hipLaunchKernelGGL(fwd_kernel, dim3(grid), dim3(NTHREADS), LDS_BYTES, stream, a);
#endif
    const hipError_t le = hipPeekAtLastError();
    if (le != hipSuccess) fprintf(stderr, "kernel_launch: launch failed: %s\n", hipGetErrorName(le));
}
```
